# Optimizing an MI355X kernel written in HIP

```python
import jax, jax.numpy as jnp
from jax import lax
import numpy as np

D_MODEL = 1024
BATCH = 8
SEQ = 4096
DEPTH = 2

CHUNK = 64
EPS = 1e-6
D_MIX = D_MODEL
A_WIDTH = D_MIX // 4
A_HEADS = 4
A_HEAD_DIM = A_WIDTH // A_HEADS
SGU_BLOCK = 128
B_WIDTH = D_MIX // 4
POOL_WINDOWS = (2, 4, 8, 16)
B_GROUPS = len(POOL_WINDOWS)
B_GROUP_DIM = B_WIDTH // B_GROUPS
C_WIDTH = D_MIX - A_WIDTH - B_WIDTH
C_HEADS = 8
C_HEAD_DIM = C_WIDTH // C_HEADS
CONV_WIDTH = 4
LRU_C = 8.0
SPLIT_SIZES = (A_WIDTH, A_WIDTH, A_WIDTH, B_WIDTH, B_WIDTH, C_WIDTH, C_WIDTH)
D_IN = sum(SPLIT_SIZES)
SPLIT_POINTS = tuple(int(v) for v in np.cumsum(SPLIT_SIZES)[:-1])

kernel_name = 'hybrid_sgu_pool_rglru_parallel_heads'


def rmsnorm(x, g):
    xf = x.astype(jnp.float32)
    y = xf * lax.rsqrt(jnp.mean(xf * xf, axis=-1, keepdims=True) + EPS) * g.astype(jnp.float32)
    return y.astype(x.dtype)


def sgu_mixer(u, v, norm_g, w_s, b_s):
    bsz, s, _ = v.shape
    v = rmsnorm(v, norm_g)
    vb = v.reshape(bsz, s // SGU_BLOCK, SGU_BLOCK, A_HEADS, A_HEAD_DIM)
    chunk_id = jnp.arange(SGU_BLOCK) // CHUNK
    mask = (chunk_id[None, :] <= chunk_id[:, None]).astype(w_s.dtype)
    w = w_s * mask[None]
    y = jnp.einsum('hij,bnjhd->bnihd', w, vb) + b_s.T[None, None, :, :, None]
    return u * y.reshape(bsz, s, A_WIDTH)


def pool_mixer(xb, w_pool, b_pool, scale):
    bsz, s, _ = xb.shape
    xf = xb.astype(jnp.float32)
    cs = jnp.concatenate([jnp.zeros((bsz, 1, B_WIDTH), jnp.float32), jnp.cumsum(xf, axis=1)], axis=1)
    t = jnp.arange(s)
    outs = []
    for g, win in enumerate(POOL_WINDOWS):
        sl = slice(g * B_GROUP_DIM, (g + 1) * B_GROUP_DIM)
        c = cs[..., sl]
        upper = c[:, 1:]
        lower = jnp.pad(c[:, :s + 1 - win], ((0, 0), (win - 1, 0), (0, 0)))
        count = jnp.minimum(t + 1, win).astype(jnp.float32)[None, :, None]
        outs.append((upper - lower) / count - xf[..., sl])
    p = jnp.stack(outs, axis=2).astype(xb.dtype)
    y = jnp.einsum('bsgi,gio->bsgo', p, w_pool).reshape(bsz, s, B_WIDTH) + b_pool
    return y * scale


def rglru_mixer(xc, conv_w, conv_b, w_a, b_a, w_x, b_x, lam):
    bsz, s, _ = xc.shape
    xp = jnp.pad(xc, ((0, 0), (CONV_WIDTH - 1, 0), (0, 0)))
    conv = conv_b + sum(xp[:, k:k + s] * conv_w[k] for k in range(CONV_WIDTH))
    xh = conv.reshape(bsz, s, C_HEADS, C_HEAD_DIM)
    r = jax.nn.sigmoid(jnp.einsum('bshi,hio->bsho', xh, w_a).reshape(bsz, s, C_WIDTH) + b_a)
    i = jax.nn.sigmoid(jnp.einsum('bshi,hio->bsho', xh, w_x).reshape(bsz, s, C_WIDTH) + b_x)
    log_a = -LRU_C * r.astype(jnp.float32) * jax.nn.softplus(-lam.astype(jnp.float32))
    a = jnp.exp(log_a)
    mult = jnp.sqrt(-jnp.expm1(2.0 * log_a))
    bterm = mult * (i * conv).astype(jnp.float32)

    def combine(left, right):
        a1, b1 = left
        a2, b2 = right
        return a1 * a2, a2 * b1 + b2

    _, h = lax.associative_scan(combine, (a, bterm), axis=1)
    return h.astype(xc.dtype)


def setup_inputs(seed: int = 0) -> dict:
    key = jax.random.key(seed)
    ks = jax.random.split(key, 20)
    f32 = jnp.float32
    x = jax.random.normal(ks[0], (BATCH, SEQ, D_MODEL), f32)
    norm_g = 1.0 + 0.1 * jax.random.normal(ks[1], (DEPTH, D_MODEL), f32)
    w_in = jax.random.normal(ks[2], (DEPTH, D_MODEL, D_IN), f32) * D_MODEL ** -0.5
    sgu_norm_g = 1.0 + 0.1 * jax.random.normal(ks[3], (DEPTH, A_WIDTH), f32)
    sgu_w = jax.random.normal(ks[4], (DEPTH, A_HEADS, SGU_BLOCK, SGU_BLOCK), f32) * SGU_BLOCK ** -0.5
    sgu_b = 1.0 + 0.1 * jax.random.normal(ks[5], (DEPTH, A_HEADS, SGU_BLOCK), f32)
    pool_w = jax.random.normal(ks[6], (DEPTH, B_GROUPS, B_GROUP_DIM, B_GROUP_DIM), f32) * B_GROUP_DIM ** -0.5
    pool_b = 0.02 * jax.random.normal(ks[7], (DEPTH, B_WIDTH), f32)
    pool_scale = 1.0 + 0.1 * jax.random.normal(ks[8], (DEPTH, B_WIDTH), f32)
    conv_w = jax.random.normal(ks[9], (DEPTH, CONV_WIDTH, C_WIDTH), f32) * CONV_WIDTH ** -0.5
    conv_b = 0.02 * jax.random.normal(ks[10], (DEPTH, C_WIDTH), f32)
    lru_wa = jax.random.normal(ks[11], (DEPTH, C_HEADS, C_HEAD_DIM, C_HEAD_DIM), f32) * C_HEAD_DIM ** -0.5
    lru_ba = 0.02 * jax.random.normal(ks[12], (DEPTH, C_WIDTH), f32)
    lru_wx = jax.random.normal(ks[13], (DEPTH, C_HEADS, C_HEAD_DIM, C_HEAD_DIM), f32) * C_HEAD_DIM ** -0.5
    lru_bx = 0.02 * jax.random.normal(ks[14], (DEPTH, C_WIDTH), f32)
    u = jax.random.uniform(ks[15], (DEPTH, C_WIDTH), f32, 0.9, 0.999)
    a0 = u ** (1.0 / LRU_C)
    lru_lambda = jnp.log(a0) - jnp.log1p(-a0)
    branch_norm_g = 1.0 + 0.1 * jax.random.normal(ks[16], (DEPTH, D_MIX), f32)
    w_out = jax.random.normal(ks[17], (DEPTH, D_MIX, D_MODEL), f32) * D_MIX ** -0.5
    final_g = 1.0 + 0.1 * jax.random.normal(ks[18], (D_MODEL,), f32)
    return {'x': x, 'norm_g': norm_g, 'w_in': w_in, 'sgu_norm_g': sgu_norm_g, 'sgu_w': sgu_w,
            'sgu_b': sgu_b, 'pool_w': pool_w, 'pool_b': pool_b, 'pool_scale': pool_scale,
            'conv_w': conv_w, 'conv_b': conv_b, 'lru_wa': lru_wa, 'lru_ba': lru_ba,
            'lru_wx': lru_wx, 'lru_bx': lru_bx, 'lru_lambda': lru_lambda,
            'branch_norm_g': branch_norm_g, 'w_out': w_out, 'final_g': final_g}


def reference(x, norm_g, w_in, sgu_norm_g, sgu_w, sgu_b, pool_w, pool_b, pool_scale,
              conv_w, conv_b, lru_wa, lru_ba, lru_wx, lru_bx, lru_lambda,
              branch_norm_g, w_out, final_g):
    for l in range(DEPTH):
        h = rmsnorm(x, norm_g[l])
        proj = jnp.einsum('bsd,de->bse', h, w_in[l])
        a_u, a_v, a_z, b_x, b_z, c_x, c_z = jnp.split(proj, SPLIT_POINTS, axis=-1)
        ya = sgu_mixer(a_u, a_v, sgu_norm_g[l], sgu_w[l], sgu_b[l])
        yb = pool_mixer(b_x, pool_w[l], pool_b[l], pool_scale[l])
        yc = rglru_mixer(c_x, conv_w[l], conv_b[l], lru_wa[l], lru_ba[l], lru_wx[l], lru_bx[l], lru_lambda[l])
        g = branch_norm_g[l]
        ya = rmsnorm(ya, g[:A_WIDTH]) * jax.nn.silu(a_z)
        yb = rmsnorm(yb, g[A_WIDTH:A_WIDTH + B_WIDTH]) * jax.nn.silu(b_z)
        yc = rmsnorm(yc, g[A_WIDTH + B_WIDTH:]) * jax.nn.silu(c_z)
        y = jnp.concatenate([ya, yb, yc], axis=-1)
        x = x + jnp.einsum('bse,ed->bsd', y, w_out[l])
    return rmsnorm(x, final_g)
```

```cpp
#include <hip/hip_runtime.h>
#include <hip/hip_cooperative_groups.h>
#include <cstdio>
#include <cstdint>
namespace cg = cooperative_groups;
namespace pg8 {
#define PG8_LAS __attribute__((address_space(3)))
typedef unsigned short bf16_t;
typedef short bf16x8 __attribute__((ext_vector_type(8)));
typedef float f32x4 __attribute__((ext_vector_type(4)));
typedef unsigned u32x4 __attribute__((ext_vector_type(4)));
constexpr int BM = 256, BK = 64, HALF = 128, HTB = HALF * BK * 2  , STAGE_BYTES = 8 * HTB, NXCD = 8, WGM = 8;

__host__ __device__ __forceinline__ int lds_byte(int r, int c) { const int st = (r >> 4) * 2 + (c >> 5), rr = r & 15, cc = c & 31, ob = rr * 64 + cc * 2; return st * 1024 + (ob ^ (((ob >> 9) & 1) << 5)); }
__host__ __device__ __forceinline__ void stage_rc(int b, int& R, int& C) { const int st = b / 1024, sb = b % 1024, swz = sb ^ (((sb >> 9) & 1) << 5); R = (st >> 1) * 16 + swz / 64; C = (st & 1) * 32 + (swz % 64) / 2; }
__host__ __device__ __forceinline__ int perm32(int rho) { const int n = rho >> 4, i = rho & 15; return 8 * (i >> 2) + 4 * n + (i & 3); }

struct Unit { int pm, pn; };
struct Gemm { const bf16_t* A; const bf16_t* Bt; int M, N, K; };

struct StaticOrder {
    int nM, nN, nwg, G, c;
    __host__ __device__ void init(int M, int N, int G_, int c_) { nM = M / BM; nN = N / BM; nwg = nM * nN; G = G_; c = c_; }
    __host__ __device__ bool next(int i, Unit& u) const {
        const long L = (long)i * G + c; if (L >= nwg) return false;
        int wgid = (int)L; { const int q = nwg / NXCD, r = nwg % NXCD, xcd = wgid % NXCD, off = wgid / NXCD; wgid = (xcd < r ? xcd * (q + 1) : r * (q + 1) + (xcd - r) * q) + off; }
        const int nig = WGM * nN, gid = wgid / nig, fm = gid * WGM, gsz = (nM - fm) < WGM ? (nM - fm) : WGM;
        u.pm = fm + ((wgid % nig) % gsz); u.pn = (wgid % nig) / gsz; return true;
    }
    __device__ __forceinline__ void a_ready(const Unit&) const {}
    __device__ __forceinline__ void done(const Unit&) const {}
};

__device__ __forceinline__ unsigned cvt_pk_bf16(float lo, float hi) { unsigned r; asm volatile("v_cvt_pk_bf16_f32 %0, %1, %2" : "=v"(r) : "v"(lo), "v"(hi)); return r; }

struct EpiProj {
    static constexpr bool PERM = true, AFTER_DRAIN = false;
    bf16_t* O; const float* rowss; int ldc;
    __device__ __forceinline__ void operator()(const f32x4 (&acc)[2][2][4][2], const Unit& u, int wr, int wc, int fr, int fq) const {
        const int row0 = u.pm * BM + wr * 64 + fr, col0 = u.pn * BM + wc * 32 + 8 * fq;
#pragma unroll
        for (int ai = 0; ai < 2; ++ai)
#pragma unroll
            for (int m = 0; m < 4; ++m) {
                const int row = row0 + ai * HALF + m * 16;
                const float rs = __builtin_amdgcn_rsqf(rowss[row] * (1.0f / 1024.0f) + 1e-6f);
                bf16_t* rowp = O + (size_t)row * ldc + col0;
#pragma unroll
                for (int bj = 0; bj < 2; ++bj) { const f32x4 v0 = acc[ai][bj][m][0] * rs, v1 = acc[ai][bj][m][1] * rs;
                    u32x4 w; w.x = cvt_pk_bf16(v0[0], v0[1]); w.y = cvt_pk_bf16(v0[2], v0[3]); w.z = cvt_pk_bf16(v1[0], v1[1]); w.w = cvt_pk_bf16(v1[2], v1[3]);
                    *(u32x4*)(rowp + bj * HALF) = w; }
            }
    }
};
struct EpiOut {
    static constexpr bool PERM = true, AFTER_DRAIN = false;
    const float* resid; float* out; bf16_t* hb; float* rowss;
    __device__ __forceinline__ void operator()(const f32x4 (&acc)[2][2][4][2], const Unit& u, int wr, int wc, int fr, int fq) const {
        const int row0 = u.pm * BM + wr * 64 + fr, col0 = u.pn * BM + wc * 32 + 8 * fq;
#pragma unroll
        for (int ai = 0; ai < 2; ++ai)
#pragma unroll
            for (int m = 0; m < 4; ++m) {
                const int row = row0 + ai * HALF + m * 16;
                const size_t off = (size_t)row * 1024 + col0;
                float ss = 0.f;
#pragma unroll
                for (int bj = 0; bj < 2; ++bj) {
                    const f32x4 r0 = *(const f32x4*)(resid + off + bj * HALF), r1 = *(const f32x4*)(resid + off + bj * HALF + 4);
                    const f32x4 v0 = acc[ai][bj][m][0] + r0, v1 = acc[ai][bj][m][1] + r1;
                    *(f32x4*)(out + off + bj * HALF) = v0; *(f32x4*)(out + off + bj * HALF + 4) = v1;
                    ss += (v0[0] * v0[0] + v0[1] * v0[1]) + (v0[2] * v0[2] + v0[3] * v0[3]) + (v1[0] * v1[0] + v1[1] * v1[1]) + (v1[2] * v1[2] + v1[3] * v1[3]);
                    if (hb) { u32x4 w; w.x = cvt_pk_bf16(v0[0], v0[1]); w.y = cvt_pk_bf16(v0[2], v0[3]); w.z = cvt_pk_bf16(v1[0], v1[1]); w.w = cvt_pk_bf16(v1[2], v1[3]);
                        *(u32x4*)(hb + off + bj * HALF) = w; }
                }
                ss += __shfl_xor(ss, 16); ss += __shfl_xor(ss, 32);
                if (fq == 0) unsafeAtomicAdd(rowss + row, ss);
            }
    }
};

template <class Epi, class Sched, bool ALIGN_EPI = false, bool SP2 = false>
__device__ __forceinline__ void gemm_phase(PG8_LAS unsigned char* lds, const Gemm g, const Sched& S, const Epi& E) {
    int tid_ = threadIdx.x; asm volatile("" : "+v"(tid_));
    const int tid = tid_, wid = __builtin_amdgcn_readfirstlane(tid >> 6), lane = tid & 63, wr = wid >> 2, wc = wid & 3, fr = lane & 15, fq = lane >> 4;
    const int K = g.K, nt = K / BK;
    unsigned voffA[2], voffB[2];
#pragma unroll
    for (int i = 0; i < 2; ++i) { int R, C; stage_rc(tid * 16 + i * 8192, R, C); const int Rb = Epi::PERM ? ((R & ~31) + perm32(R & 31)) : R;
        voffA[i] = (unsigned)(R * K + C) * 2u; voffB[i] = (unsigned)(Rb * K + C) * 2u; }
    const size_t kstep = (size_t)(BK * 2);
    const size_t hstep = (size_t)HALF * K * 2;
    const size_t tstep = 2 * hstep;
    const unsigned ldsw = (unsigned)wid * 1024u;
    const int aoff = lds_byte(wr * 64 + fr, fq * 8), boff = lds_byte(wc * 32 + fr, fq * 8);
#define PG8_SA(b, h) (((b) * 2 + (h)) * HTB)
#define PG8_SB(b, h) ((4 + (b) * 2 + (h)) * HTB)
#define PG8_STAGE(bufoff, gbase, voff) do { _Pragma("unroll") for (int _i = 0; _i < 2; ++_i) \
        __builtin_amdgcn_global_load_lds((const unsigned*)((const char*)(gbase) + (voff)[_i]), (PG8_LAS unsigned*)(lds + (bufoff) + ldsw + _i * 8192), 16, 0, 0); } while (0)
#define PG8_LDA(dst, b, h) do { _Pragma("unroll") for (int m = 0; m < 4; ++m) _Pragma("unroll") for (int k = 0; k < 2; ++k) dst[m][k] = *(const PG8_LAS bf16x8*)(lds + PG8_SA(b, h) + aoff + m * 2048 + k * 1024); } while (0)
#define PG8_LDB(dst, b, h) do { _Pragma("unroll") for (int n = 0; n < 2; ++n) _Pragma("unroll") for (int k = 0; k < 2; ++k) dst[n][k] = *(const PG8_LAS bf16x8*)(lds + PG8_SB(b, h) + boff + n * 2048 + k * 1024); } while (0)
#define PG8_MMA(ai, bj, At, Bt) do { __builtin_amdgcn_s_setprio(1); _Pragma("unroll") for (int m = 0; m < 4; ++m) _Pragma("unroll") for (int n = 0; n < 2; ++n) _Pragma("unroll") for (int k = 0; k < 2; ++k) \
        acc[ai][bj][m][n] = __builtin_amdgcn_mfma_f32_16x16x32_bf16(Bt[n][k], At[m][k], acc[ai][bj][m][n], 0, 0, 0); __builtin_amdgcn_s_setprio(0); } while (0)
#define PG8_WAIT_V(n) asm volatile("s_waitcnt vmcnt(" #n ")" ::: "memory")
#define PG8_WAIT_L(n) asm volatile("s_waitcnt lgkmcnt(" #n ")" ::: "memory")
#define PG8_BAR __builtin_amdgcn_s_barrier()
#define PG8_SCHED __builtin_amdgcn_sched_barrier(0)
    Unit cur, nxt; int ui = 0;
    if (!S.next(0, cur)) return;
    f32x4 acc[2][2][4][2];
#pragma unroll
    for (int a = 0; a < 2; ++a)
#pragma unroll
        for (int b = 0; b < 2; ++b)
#pragma unroll
            for (int m = 0; m < 4; ++m)
#pragma unroll
                for (int n = 0; n < 2; ++n) acc[a][b][m][n] = (f32x4){0.f, 0.f, 0.f, 0.f};
    bf16x8 At[4][2], B0[2][2], B1[2][2];
    const char* cA = (const char*)g.A + (size_t)cur.pm * tstep; const char* cB = (const char*)g.Bt + (size_t)cur.pn * tstep;
    S.a_ready(cur);
    if constexpr (SP2) {
        PG8_STAGE(PG8_SB(0, 0), cB, voffB); PG8_STAGE(PG8_SB(0, 1), cB + hstep, voffB); PG8_STAGE(PG8_SA(0, 0), cA, voffA); PG8_STAGE(PG8_SA(0, 1), cA + hstep, voffA);
        if (wr == 1) PG8_BAR;
        PG8_WAIT_V(2); PG8_BAR;
        PG8_STAGE(PG8_SB(1, 0), cB + kstep, voffB); PG8_STAGE(PG8_SA(1, 0), cA + kstep, voffA); PG8_STAGE(PG8_SB(1, 1), cB + hstep + kstep, voffB);
        PG8_WAIT_V(6); PG8_BAR;
    } else {
        PG8_STAGE(PG8_SB(0, 0), cB, voffB); PG8_STAGE(PG8_SA(0, 0), cA, voffA); PG8_STAGE(PG8_SB(0, 1), cB + hstep, voffB); PG8_STAGE(PG8_SA(0, 1), cA + hstep, voffA);
        if (wr == 1) PG8_BAR;
        PG8_WAIT_V(4); PG8_BAR;
        PG8_STAGE(PG8_SB(1, 0), cB + kstep, voffB); PG8_STAGE(PG8_SA(1, 0), cA + kstep, voffA); PG8_STAGE(PG8_SB(1, 1), cB + hstep + kstep, voffB);
        PG8_WAIT_V(6); PG8_BAR;
    }
    for (;;) {
        const bool has_next = S.next(ui + 1, nxt);
        const char* nA = has_next ? (const char*)g.A + (size_t)nxt.pm * tstep : cA; const char* nB = has_next ? (const char*)g.Bt + (size_t)nxt.pn * tstep : cB;
        for (int t = 0; t < nt; t += 2) {
            const bool last = (t == nt - 2);
            const char* a1 = cA + (size_t)(t + 1) * kstep;
            const char* a2 = last ? nA : cA + (size_t)(t + 2) * kstep; const char* b2 = last ? nB : cB + (size_t)(t + 2) * kstep;
            const char* a3 = a2 + kstep; const char* b3 = b2 + kstep;
            if (last && has_next) S.a_ready(nxt);
            if constexpr (SP2) {
            PG8_LDB(B0, 0, 0); PG8_LDB(B1, 0, 1); PG8_SCHED; PG8_LDA(At, 0, 0); PG8_STAGE(PG8_SA(1, 1), a1 + hstep, voffA);
            PG8_WAIT_V(8); PG8_WAIT_L(0); PG8_BAR; PG8_MMA(0, 0, At, B0); PG8_MMA(0, 1, At, B1); PG8_BAR; PG8_SCHED;
            PG8_LDA(At, 0, 1); PG8_STAGE(PG8_SB(0, 0), b2, voffB); PG8_STAGE(PG8_SB(0, 1), b2 + hstep, voffB); PG8_STAGE(PG8_SA(0, 0), a2, voffA);
            PG8_WAIT_V(8); PG8_WAIT_L(0); PG8_BAR; PG8_MMA(1, 0, At, B0); PG8_MMA(1, 1, At, B1); PG8_BAR; PG8_SCHED;
            PG8_LDB(B0, 1, 0); PG8_LDB(B1, 1, 1); PG8_SCHED; PG8_LDA(At, 1, 0); PG8_STAGE(PG8_SA(0, 1), a2 + hstep, voffA);
            PG8_WAIT_V(8); PG8_WAIT_L(0); PG8_BAR; PG8_MMA(0, 0, At, B0); PG8_MMA(0, 1, At, B1); PG8_BAR; PG8_SCHED;
            PG8_LDA(At, 1, 1); PG8_STAGE(PG8_SB(1, 0), b3, voffB); PG8_STAGE(PG8_SB(1, 1), b3 + hstep, voffB); PG8_STAGE(PG8_SA(1, 0), a3, voffA);
            PG8_WAIT_V(8); PG8_WAIT_L(0); PG8_BAR; PG8_MMA(1, 0, At, B0); PG8_MMA(1, 1, At, B1); PG8_BAR; PG8_SCHED;
            } else {
            PG8_LDB(B0, 0, 0); PG8_SCHED; PG8_LDA(At, 0, 0); PG8_STAGE(PG8_SA(1, 1), a1 + hstep, voffA);
            PG8_WAIT_L(8); PG8_BAR; PG8_WAIT_L(0); PG8_MMA(0, 0, At, B0); PG8_BAR; PG8_SCHED;
            PG8_LDB(B1, 0, 1); PG8_STAGE(PG8_SB(0, 0), b2, voffB);
            PG8_BAR; PG8_WAIT_L(0); PG8_MMA(0, 1, At, B1); PG8_BAR;
            PG8_LDA(At, 0, 1); PG8_STAGE(PG8_SA(0, 0), a2, voffA);
            PG8_BAR; PG8_WAIT_L(0); PG8_MMA(1, 0, At, B0); PG8_BAR; PG8_SCHED;
            PG8_STAGE(PG8_SB(0, 1), b2 + hstep, voffB);
            PG8_WAIT_V(6); PG8_BAR; PG8_MMA(1, 1, At, B1); PG8_BAR;
            PG8_LDB(B0, 1, 0); PG8_SCHED; PG8_LDA(At, 1, 0); PG8_STAGE(PG8_SA(0, 1), a2 + hstep, voffA);
            PG8_WAIT_L(8); PG8_BAR; PG8_WAIT_L(0); PG8_MMA(0, 0, At, B0); PG8_BAR; PG8_SCHED;
            PG8_LDB(B1, 1, 1); PG8_STAGE(PG8_SB(1, 0), b3, voffB);
            PG8_BAR; PG8_WAIT_L(0); PG8_MMA(0, 1, At, B1); PG8_BAR;
            PG8_LDA(At, 1, 1); PG8_STAGE(PG8_SA(1, 0), a3, voffA);
            PG8_BAR; PG8_WAIT_L(0); PG8_MMA(1, 0, At, B0); PG8_BAR; PG8_SCHED;
            PG8_STAGE(PG8_SB(1, 1), b3 + hstep, voffB);
            PG8_WAIT_V(6); PG8_BAR; PG8_MMA(1, 1, At, B1); PG8_BAR;
            }
        }
        if constexpr (ALIGN_EPI) { if (wr == 0) PG8_BAR; }
        if constexpr (!Epi::AFTER_DRAIN) { E(acc, cur, wr, wc, fr, fq); S.done(cur); }
        if (!has_next) break;
#pragma unroll
        for (int a = 0; a < 2; ++a)
#pragma unroll
            for (int b = 0; b < 2; ++b)
#pragma unroll
                for (int m = 0; m < 4; ++m)
#pragma unroll
                    for (int n = 0; n < 2; ++n) acc[a][b][m][n] = (f32x4){0.f, 0.f, 0.f, 0.f};
        cur = nxt; cA = nA; cB = nB; ++ui;
        if constexpr (ALIGN_EPI) { if (wr == 1) PG8_BAR; }
    }
    PG8_WAIT_V(0);
    if constexpr (!ALIGN_EPI) { if (wr == 0) PG8_BAR; }
    PG8_BAR;
    if constexpr (Epi::AFTER_DRAIN) { E.fused(acc, cur, wr, wc, fr, fq, lds, wid, lane); S.done(cur); }
#undef PG8_SA
#undef PG8_SB
#undef PG8_STAGE
#undef PG8_LDA
#undef PG8_LDB
#undef PG8_MMA
#undef PG8_WAIT_V
#undef PG8_WAIT_L
#undef PG8_BAR
#undef PG8_SCHED
}
}

constexpr int NWAVES = 8, NTHR = 512;
constexpr int MROWS = 32768, DM = 1024, DIN = 2304, SEQ = 4096, TILE = 128, NTILES = MROWS / TILE, TPS = SEQ / TILE;
constexpr int OFF_AU = 0, OFF_AV = 256, OFF_AZ = 512, OFF_BX = 768, OFF_BZ = 1024, OFF_CX = 1280, OFF_CZ = 1792;
constexpr float EPS = 1e-6f;
constexpr size_t MiB = 1u << 20;
constexpr size_t WS_WIN = 0;
constexpr size_t WS_WOUT = 9 * MiB;
constexpr size_t WS_SGUW = 13 * MiB;
constexpr size_t WS_POOLW = 13 * MiB + 256 * 1024;
constexpr size_t WS_WA = 13 * MiB + 512 * 1024;
constexpr size_t WS_WX = 13 * MiB + 768 * 1024;
constexpr size_t WS_ROWSS = 14 * MiB;
constexpr size_t WS_AGG = 15 * MiB;
constexpr size_t WS_H = 16 * MiB;
constexpr size_t WS_PROJ = 80 * MiB;
constexpr size_t WS_Y = 224 * MiB;
constexpr size_t WS_END = 288 * MiB;
constexpr int LDS_BYTES = 147456;

#define LAS __attribute__((address_space(3)))
typedef unsigned short bf16;
typedef unsigned v4u __attribute__((ext_vector_type(4)));
typedef unsigned v2u __attribute__((ext_vector_type(2)));
typedef float f32x4 __attribute__((ext_vector_type(4)));
typedef short bf16x8 __attribute__((ext_vector_type(8)));

__device__ __forceinline__ unsigned pk2(float lo, float hi) { return pg8::cvt_pk_bf16(lo, hi); }
__device__ __forceinline__ float bflo(unsigned w) { return __uint_as_float(w << 16); }
__device__ __forceinline__ float bfhi(unsigned w) { return __uint_as_float(w & 0xffff0000u); }
__device__ __forceinline__ float bf2f(bf16 b) { return __uint_as_float(((unsigned)b) << 16); }
__device__ __forceinline__ bf16 f2bf(float f) { return (bf16)(pk2(f, 0.f) & 0xffffu); }
__device__ __forceinline__ float fexp(float x) { return __builtin_amdgcn_exp2f(x * 1.4426950408889634f); }
__device__ __forceinline__ float sigm(float x) { return __builtin_amdgcn_rcpf(1.0f + fexp(-x)); }
__device__ __forceinline__ float silu(float x) { return x * sigm(x); }
__device__ __forceinline__ float wave_sum(float v) {
#pragma unroll
    for (int o = 1; o < 64; o <<= 1) v += __shfl_xor(v, o);
    return v;
}
__device__ __forceinline__ void unpack8(const v4u w, float (&x)[8]) {
    x[0] = bflo(w.x); x[1] = bfhi(w.x); x[2] = bflo(w.y); x[3] = bfhi(w.y); x[4] = bflo(w.z); x[5] = bfhi(w.z); x[6] = bflo(w.w); x[7] = bfhi(w.w);
}
__device__ __forceinline__ v4u pack8(const float (&x)[8]) { v4u w; w.x = pk2(x[0], x[1]); w.y = pk2(x[2], x[3]); w.z = pk2(x[4], x[5]); w.w = pk2(x[6], x[7]); return w; }
#define MFMA16(a, b, c) __builtin_amdgcn_mfma_f32_16x16x32_bf16((a), (b), (c), 0, 0, 0)

struct Params {
    const float* in[19];
    float* out; unsigned char* ws;
};

__device__ __forceinline__ void p0_transpose_item(const float* W, const float* gk, int K, int N, bf16* WT, LAS float* scr, int item, int lane) {
    const int nblk = N / 32, kb = item / nblk, nb = item % nblk, k0 = 64 * kb, n0 = 32 * nb;
#pragma unroll 8
    for (int i = 0; i < 32; ++i) { const int kk = 2 * i + (lane >> 5); scr[kk * 33 + (lane & 31)] = W[(size_t)(k0 + kk) * N + n0 + (lane & 31)] * gk[k0 + kk]; }
    asm volatile("s_waitcnt lgkmcnt(0)" ::: "memory");
    const int c = lane & 7;
#pragma unroll
    for (int j = 0; j < 4; ++j) { const int n = (lane >> 3) + 8 * j; const LAS float* s = scr + (8 * c) * 33 + n;
        v4u o; o.x = pk2(s[0 * 33], s[1 * 33]); o.y = pk2(s[2 * 33], s[3 * 33]); o.z = pk2(s[4 * 33], s[5 * 33]); o.w = pk2(s[6 * 33], s[7 * 33]);
        *(v4u*)(WT + (size_t)(n0 + n) * K + k0 + 8 * c) = o; }
    asm volatile("s_waitcnt lgkmcnt(0)" ::: "memory");
}
__device__ __forceinline__ void p0_prologue(const Params& p, LAS unsigned char* lds, int tid, int lane, int wave) {
    unsigned char* ws = p.ws;
    LAS float* scr = (LAS float*)(lds + wave * 16384);
    const int G = gridDim.x, gw = blockIdx.x * NWAVES + wave, NGW = G * NWAVES;
    constexpr int I_IN = (DM / 64) * (DIN / 32), I_OUT = (DM / 64) * (DM / 32);
    for (int it = gw; it < 2 * (I_IN + I_OUT); it += NGW) {
        int r = it;
        if (r < 2 * I_IN) { const int l = r / I_IN; r -= l * I_IN;
            p0_transpose_item(p.in[2] + (size_t)l * DM * DIN, p.in[1] + l * DM, DM, DIN, (bf16*)(ws + WS_WIN) + (size_t)l * DIN * DM, scr, r, lane); continue; }
        r -= 2 * I_IN; { const int l = r / I_OUT; r -= l * I_OUT;
            p0_transpose_item(p.in[17] + (size_t)l * DM * DM, p.in[16] + l * DM, DM, DM, (bf16*)(ws + WS_WOUT) + (size_t)l * DM * DM, scr, r, lane); }
    }
    const int gt = blockIdx.x * NTHR + tid, NGT = G * NTHR;
    for (int i = gt; i < 2 * 4 * 128 * 128; i += NGT) { const int jj = i & 127, ii = (i >> 7) & 127; const float m = ((jj >> 6) <= (ii >> 6)) ? 1.f : 0.f; ((bf16*)(ws + WS_SGUW))[i] = f2bf(p.in[4][i] * m); }
    for (int i = gt; i < 2 * 4 * 64 * 64; i += NGT) { const int ii = i & 63, o = (i >> 6) & 63, lg = i >> 12; ((bf16*)(ws + WS_POOLW))[i] = f2bf(p.in[6][(lg * 64 + ii) * 64 + o]); }
    for (int i = gt; i < 2 * 8 * 64 * 64; i += NGT) { const int ii = i & 63, o = (i >> 6) & 63, lh = i >> 12;
        ((bf16*)(ws + WS_WA))[i] = f2bf(p.in[11][(lh * 64 + ii) * 64 + o]); ((bf16*)(ws + WS_WX))[i] = f2bf(p.in[13][(lh * 64 + ii) * 64 + o]); }
    float* rowss = (float*)(ws + WS_ROWSS);
    for (int i = gt; i < 2 * MROWS; i += NGT) rowss[MROWS + i] = 0.f;
    const float* x = p.in[0]; bf16* hb = (bf16*)(ws + WS_H);
    for (int m = gw; m < MROWS; m += NGW) {
        const f32x4* xr = (const f32x4*)(x + (size_t)m * DM) + lane; float s = 0.f;
        unsigned long long* o8 = (unsigned long long*)(hb + (size_t)m * DM) + lane;
#pragma unroll
        for (int j = 0; j < 4; ++j) { const f32x4 v = xr[64 * j]; s += (v.x * v.x + v.y * v.y) + (v.z * v.z + v.w * v.w);
            o8[64 * j] = (unsigned long long)pk2(v.x, v.y) | ((unsigned long long)pk2(v.z, v.w) << 32); }
        s = wave_sum(s);
        if (lane == 0) rowss[m] = s;
    }
}

constexpr int L_YT = 73728, L_RSTDV = L_YT + 67584, L_HIN = 0;

__device__ __forceinline__ void mixer_c(LAS unsigned char* lds, const bf16* proj, const bf16* waT, const bf16* wxT, const float* conv_w, const float* conv_b,
                                        const float* lba, const float* lbx, const float* lam, bf16* hloc, bf16* Lbuf, float* aggL, float* aggH, int T, int wid, int lane) {
    const int h = wid, g = lane >> 4, o = lane & 15, tt = T % TPS;
    const size_t R0 = (size_t)T * TILE;
    LAS unsigned char* cimg = lds + wid * 9216;
    bf16x8 WA[4][2], WX[4][2];
#pragma unroll
    for (int n = 0; n < 4; ++n)
#pragma unroll
        for (int kk = 0; kk < 2; ++kk) { const int idx = (h * 64 + 16 * n + o) * 64 + 32 * kk + 8 * g; WA[n][kk] = *(const bf16x8*)(waT + idx); WX[n][kk] = *(const bf16x8*)(wxT + idx); }
    float pba[4], pbx[4], psp[4], hc[4], Lc[4];
#pragma unroll
    for (int n = 0; n < 4; ++n) { const int c = 64 * h + 16 * n + o; pba[n] = lba[c]; pbx[n] = lbx[c];
        const float xm = -lam[c]; psp[n] = -8.0f * (fmaxf(xm, 0.f) + log1pf(expf(-fabsf(xm)))); hc[n] = 0.f; Lc[n] = 0.f; }
#pragma unroll 1
    for (int half = 0; half < 2; ++half) {
        {
            const int oc = lane & 15, seg = lane >> 4, cc = 64 * h + 4 * oc;
            f32x4 cw0 = *(const f32x4*)(conv_w + cc), cw1 = *(const f32x4*)(conv_w + 512 + cc), cw2 = *(const f32x4*)(conv_w + 1024 + cc), cw3 = *(const f32x4*)(conv_w + 1536 + cc), cb = *(const f32x4*)(conv_b + cc);
            const int t0 = 64 * half + 16 * seg;
            const bf16* base = proj + (R0 + t0) * DIN + OFF_CX + cc;
            f32x4 x0 = {0.f, 0.f, 0.f, 0.f}, x1 = x0, x2 = x0;
            const bool pv = (t0 > 0) || (tt > 0);
            if (pv) { v2u w; w = *(const v2u*)(base - 3 * DIN); x0 = (f32x4){bflo(w.x), bfhi(w.x), bflo(w.y), bfhi(w.y)};
                w = *(const v2u*)(base - 2 * DIN); x1 = (f32x4){bflo(w.x), bfhi(w.x), bflo(w.y), bfhi(w.y)};
                w = *(const v2u*)(base - 1 * DIN); x2 = (f32x4){bflo(w.x), bfhi(w.x), bflo(w.y), bfhi(w.y)}; }
#pragma unroll 4
            for (int r = 0; r < 16; ++r) {
                const v2u w = *(const v2u*)(base + r * DIN); const f32x4 cur = {bflo(w.x), bfhi(w.x), bflo(w.y), bfhi(w.y)};
                const f32x4 cv = cb + cw0 * x0 + cw1 * x1 + cw2 * x2 + cw3 * cur; x0 = x1; x1 = x2; x2 = cur;
                v2u ov; ov.x = pk2(cv.x, cv.y); ov.y = pk2(cv.z, cv.w);
                *(LAS v2u*)(cimg + (16 * seg + r) * 144 + oc * 8) = ov;
            }
        }
        asm volatile("s_waitcnt lgkmcnt(0)" ::: "memory");
#pragma unroll 1
        for (int mm = 0; mm < 4; ++mm) {
            const int m = 4 * half + mm;
            bf16x8 XA[2];
#pragma unroll
            for (int kk = 0; kk < 2; ++kk) XA[kk] = *(const LAS bf16x8*)(cimg + (16 * mm + o) * 144 + (32 * kk + 8 * g) * 2);
#pragma unroll
            for (int n = 0; n < 4; ++n) {
                f32x4 Da = {0.f, 0.f, 0.f, 0.f}, Dx = {0.f, 0.f, 0.f, 0.f};
                Da = MFMA16(XA[0], WA[n][0], Da); Da = MFMA16(XA[1], WA[n][1], Da);
                Dx = MFMA16(XA[0], WX[n][0], Dx); Dx = MFMA16(XA[1], WX[n][1], Dx);
                float Hr[4], Lr[4], Hrun = 0.f, Lrun = 0.f;
#pragma unroll
                for (int reg = 0; reg < 4; ++reg) {
                    const float cv = bf2f(*(const LAS bf16*)(cimg + (16 * mm + 4 * g + reg) * 144 + (16 * n + o) * 2));
                    const float r = sigm(Da[reg] + pba[n]), ig = sigm(Dx[reg] + pbx[n]);
                    const float la = psp[n] * r, a = fexp(la), x2v = 2.0f * la;
                    const float ser = -x2v * (1.0f + x2v * (0.5f + x2v * (0.16666667f + x2v * (0.041666668f + x2v * 0.0083333338f))));
                    const float em = (x2v > -0.25f) ? ser : (1.0f - fexp(x2v));
                    const float b = __builtin_amdgcn_sqrtf(em) * ig * cv;
                    Hrun = a * Hrun + b; Lrun += la; Hr[reg] = Hrun; Lr[reg] = Lrun;
                }
                float Lt = Lrun, Ht = Hrun;
                { const float Lp = __shfl_up(Lt, 16), Hp = __shfl_up(Ht, 16); if (g >= 1) { Ht = fexp(Lt) * Hp + Ht; Lt = Lp + Lt; } }
                { const float Lp = __shfl_up(Lt, 32), Hp = __shfl_up(Ht, 32); if (g >= 2) { Ht = fexp(Lt) * Hp + Ht; Lt = Lp + Lt; } }
                float Le = __shfl_up(Lt, 16), He = __shfl_up(Ht, 16); if (g == 0) { Le = 0.f; He = 0.f; }
                const float Hpre = fexp(Le) * hc[n] + He, Lpre = Lc[n] + Le;
                float hv = 0.f, lv = 0.f;
                const size_t so = (R0 + 16 * m + 4 * g) * 512 + 64 * h + 16 * n + o;
#pragma unroll
                for (int reg = 0; reg < 4; ++reg) { hv = Hr[reg] + fexp(Lr[reg]) * Hpre; lv = Lr[reg] + Lpre; hloc[so + reg * 512] = f2bf(hv); Lbuf[so + reg * 512] = f2bf(lv); }
                hc[n] = __shfl(hv, 48 + o); Lc[n] = __shfl(lv, 48 + o);
            }
        }
    }
    if (g == 0) {
#pragma unroll
        for (int n = 0; n < 4; ++n) { const int c = 64 * h + 16 * n + o; aggL[(size_t)T * 512 + c] = Lc[n]; aggH[(size_t)T * 512 + c] = hc[n]; } }
}

__device__ __forceinline__ void finish_rows(LAS unsigned char* ytile, const bf16* mulp, const bf16* zp, bf16* outp, int tid) {
    const int c8 = 8 * (tid & 31), tb = tid >> 5;
#pragma unroll 2
    for (int i = 0; i < 8; ++i) { const int t = tb + 16 * i;
        float y[8], z[8]; unpack8(*(const LAS v4u*)(ytile + t * 528 + c8 * 2), y); unpack8(*(const v4u*)(zp + (size_t)t * DIN + c8), z);
        if (mulp) { float u[8]; unpack8(*(const v4u*)(mulp + (size_t)t * DIN + c8), u);
#pragma unroll
            for (int e = 0; e < 8; ++e) y[e] *= u[e]; }
        float ss = 0.f;
#pragma unroll
        for (int e = 0; e < 8; ++e) ss += y[e] * y[e];
        ss += __shfl_xor(ss, 1); ss += __shfl_xor(ss, 2); ss += __shfl_xor(ss, 4); ss += __shfl_xor(ss, 8); ss += __shfl_xor(ss, 16);
        const float rstd = __builtin_amdgcn_rsqf(ss * (1.0f / 256.0f) + EPS);
#pragma unroll
        for (int e = 0; e < 8; ++e) y[e] = y[e] * rstd * silu(z[e]);
        *(v4u*)(outp + (size_t)t * DM + c8) = pack8(y); }
}

__device__ __forceinline__ void mixer_a(LAS unsigned char* lds, const bf16* proj, const bf16* sguW, const float* sgu_g, const float* sgu_b, bf16* ybuf, int T, int tid, int wid, int lane) {
    const int g = lane >> 4, o = lane & 15;
    const size_t R0 = (size_t)T * TILE;
    LAS float* rstdv = (LAS float*)(lds + L_RSTDV); LAS unsigned char* ytile = lds + L_YT;
#pragma unroll 4
    for (int rr = 0; rr < 16; ++rr) { const int j = 16 * wid + rr; const v2u w = *(const v2u*)(proj + (R0 + j) * DIN + OFF_AV + 4 * lane);
        const float a = bflo(w.x), b = bfhi(w.x), c = bflo(w.y), d = bfhi(w.y); const float s = wave_sum((a * a + b * b) + (c * c + d * d));
        if (lane == 0) rstdv[j] = __builtin_amdgcn_rsqf(s * (1.0f / 256.0f) + EPS); }
    __syncthreads();
    { const int jo = tid & 15, co = tid >> 4;
        float sg[8]; { const f32x4 a = *(const f32x4*)(sgu_g + 8 * co), b = *(const f32x4*)(sgu_g + 8 * co + 4); sg[0] = a.x; sg[1] = a.y; sg[2] = a.z; sg[3] = a.w; sg[4] = b.x; sg[5] = b.y; sg[6] = b.z; sg[7] = b.w; }
        v4u rows[8]; float rs[8];
#pragma unroll
        for (int r = 0; r < 8; ++r) { rows[r] = *(const v4u*)(proj + (R0 + 8 * jo + r) * DIN + OFF_AV + 8 * co); rs[r] = rstdv[8 * jo + r]; }
#pragma unroll
        for (int e = 0; e < 8; ++e) { float v[8];
#pragma unroll
            for (int r = 0; r < 8; ++r) { const unsigned w = rows[r][e >> 1]; v[r] = ((e & 1) ? bfhi(w) : bflo(w)) * rs[r] * sg[e]; }
            *(LAS v4u*)(lds + (8 * co + e) * 272 + 16 * jo) = pack8(v); }
    }
    __syncthreads();
    const int h = wid & 3, hf = wid >> 2;
#pragma unroll 1
    for (int m = 0; m < 4; ++m) {
        f32x4 D[4];
#pragma unroll
        for (int n = 0; n < 4; ++n) D[n] = (f32x4){0.f, 0.f, 0.f, 0.f};
        const bf16* xw = sguW + ((h * 128 + 64 * hf + 16 * m + o) * 128 + 8 * g);
#pragma unroll
        for (int kk = 0; kk < 4; ++kk) if (kk < 2 || hf) {
            const bf16x8 X = *(const bf16x8*)(xw + 32 * kk);
#pragma unroll
            for (int n = 0; n < 4; ++n) { const bf16x8 Y = *(const LAS bf16x8*)(lds + (64 * h + 16 * n + o) * 272 + (32 * kk + 8 * g) * 2); D[n] = MFMA16(X, Y, D[n]); }
        }
        const int tb = 64 * hf + 16 * m + 4 * g;
        const f32x4 bias = *(const f32x4*)(sgu_b + h * 128 + tb);
#pragma unroll
        for (int reg = 0; reg < 4; ++reg)
#pragma unroll
            for (int n = 0; n < 4; ++n) *(LAS bf16*)(ytile + (tb + reg) * 528 + (64 * h + 16 * n + o) * 2) = f2bf(D[n][reg] + bias[reg]);
    }
    __syncthreads();
    finish_rows(ytile, proj + R0 * DIN + OFF_AU, proj + R0 * DIN + OFF_AZ, ybuf + R0 * DM, tid);
}

__device__ __forceinline__ void mixer_b(LAS unsigned char* lds, const bf16* proj, const bf16* poolWT, const float* pool_b, const float* pool_s, bf16* ybuf, int T, int tid, int wid, int lane) {
    const int g = lane >> 4, o = lane & 15, tt = T % TPS;
    const size_t R0 = (size_t)T * TILE;
    LAS unsigned char* ytile = lds + L_YT;
    {
        const int oc = tid & 31, seg = tid >> 5, grp = oc >> 3, win = 2 << grp, t0 = 8 * seg;
        const bf16* base = proj + R0 * DIN + OFF_BX + 8 * oc;
        float S[8];
#pragma unroll
        for (int e = 0; e < 8; ++e) S[e] = 0.f;
#pragma unroll 1
        for (int k = 1; k < win; ++k) { const int t = t0 - k; if (t >= 0 || tt > 0) { float x[8]; unpack8(*(const v4u*)(base + (long)t * DIN), x);
#pragma unroll
                for (int e = 0; e < 8; ++e) S[e] += x[e]; } }
        const int pos0 = tt * TILE + t0;
#pragma unroll 1
        for (int r = 0; r < 8; ++r) { const int t = t0 + r; float cur[8], pv[8]; unpack8(*(const v4u*)(base + (long)t * DIN), cur);
            const int cnt = min(pos0 + r + 1, win); const float inv = 1.0f / (float)cnt;
#pragma unroll
            for (int e = 0; e < 8; ++e) { S[e] += cur[e]; pv[e] = S[e] * inv - cur[e]; }
            *(LAS v4u*)(lds + t * 528 + oc * 16) = pack8(pv);
            const int told = t - win + 1;
            if (told >= 0 || tt > 0) { float x[8]; unpack8(*(const v4u*)(base + (long)told * DIN), x);
#pragma unroll
                for (int e = 0; e < 8; ++e) S[e] -= x[e]; }
        }
    }
    __syncthreads();
    const int gg = wid & 3, hf = wid >> 2;
    bf16x8 Y[4][2]; float pb[4], ps[4];
#pragma unroll
    for (int n = 0; n < 4; ++n) { const int c = 64 * gg + 16 * n + o; pb[n] = pool_b[c]; ps[n] = pool_s[c];
#pragma unroll
        for (int kk = 0; kk < 2; ++kk) Y[n][kk] = *(const bf16x8*)(poolWT + ((gg * 64 + 16 * n + o) * 64 + 32 * kk + 8 * g)); }
#pragma unroll 1
    for (int m = 0; m < 4; ++m) {
        f32x4 D[4];
#pragma unroll
        for (int n = 0; n < 4; ++n) D[n] = (f32x4){0.f, 0.f, 0.f, 0.f};
#pragma unroll
        for (int kk = 0; kk < 2; ++kk) { const bf16x8 X = *(const LAS bf16x8*)(lds + (64 * hf + 16 * m + o) * 528 + (64 * gg + 32 * kk + 8 * g) * 2);
#pragma unroll
            for (int n = 0; n < 4; ++n) D[n] = MFMA16(X, Y[n][kk], D[n]); }
        const int tb = 64 * hf + 16 * m + 4 * g;
#pragma unroll
        for (int reg = 0; reg < 4; ++reg)
#pragma unroll
            for (int n = 0; n < 4; ++n) *(LAS bf16*)(ytile + (tb + reg) * 528 + (64 * gg + 16 * n + o) * 2) = f2bf((D[n][reg] + pb[n]) * ps[n]);
    }
    __syncthreads();
    finish_rows(ytile, (const bf16*)nullptr, proj + R0 * DIN + OFF_BZ, ybuf + R0 * DM + 256, tid);
}

__device__ __forceinline__ void p3_tile(LAS unsigned char* lds, const bf16* proj, const bf16* hloc, const bf16* Lbuf, const float* aggL, const float* aggH, bf16* ybuf, int T, int tid, int wid, int lane) {
    const int tt = T % TPS; const size_t R0 = (size_t)T * TILE;
    LAS float* hin = (LAS float*)(lds + L_HIN);
    { float hcar = 0.f; const int Tb = T - tt;
        for (int j = 0; j < tt; ++j) { const float L = aggL[(size_t)(Tb + j) * 512 + tid], H = aggH[(size_t)(Tb + j) * 512 + tid]; hcar = fexp(L) * hcar + H; }
        hin[tid] = hcar; }
    __syncthreads();
    float hi[8];
#pragma unroll
    for (int e = 0; e < 8; ++e) hi[e] = hin[8 * lane + e];
#pragma unroll 2
    for (int rr = 0; rr < 16; ++rr) { const int t = wid + 8 * rr; const size_t row = R0 + t;
        float hl[8], L[8], z[8], hv[8];
        unpack8(*(const v4u*)(hloc + row * 512 + 8 * lane), hl); unpack8(*(const v4u*)(Lbuf + row * 512 + 8 * lane), L); unpack8(*(const v4u*)(proj + row * DIN + OFF_CZ + 8 * lane), z);
        float ss = 0.f;
#pragma unroll
        for (int e = 0; e < 8; ++e) { hv[e] = hl[e] + fexp(L[e]) * hi[e]; ss += hv[e] * hv[e]; }
        ss = wave_sum(ss); const float rstd = __builtin_amdgcn_rsqf(ss * (1.0f / 512.0f) + EPS);
#pragma unroll
        for (int e = 0; e < 8; ++e) hv[e] = hv[e] * rstd * silu(z[e]);
        *(v4u*)(ybuf + row * DM + 512 + 8 * lane) = pack8(hv);
    }
    __syncthreads();
}

typedef __attribute__((address_space(4))) const unsigned long long* kptr_t;
__device__ __forceinline__ unsigned long long karg(int i) { kptr_t k = (kptr_t)__builtin_amdgcn_kernarg_segment_ptr(); asm volatile("" : "+s"(k)); return k[i]; }
#define KIN(i) ((const float*)karg(i))
#define KOUT ((float*)karg(19))
#define KWS ((unsigned char*)karg(20))

__global__ void __launch_bounds__(NTHR, 2) hybrid_fwd(Params p) {
    extern __shared__ __attribute__((aligned(16))) unsigned char lds_raw[];
    cg::grid_group grid = cg::this_grid();
    LAS unsigned char* lds = (LAS unsigned char*)lds_raw;
#ifndef NO_P0
    { const int tid = threadIdx.x; p0_prologue(p, lds, tid, tid & 63, __builtin_amdgcn_readfirstlane(tid >> 6)); }
#endif
    grid.sync();
#pragma unroll 1
    for (int l = 0; l < 2; ++l) {
#ifndef NO_P1
        {
            unsigned char* ws = KWS;
            pg8::Gemm g{(const bf16*)(ws + WS_H), (const bf16*)(ws + WS_WIN) + (size_t)l * DIN * DM, MROWS, DIN, DM}; pg8::StaticOrder S; S.init(MROWS, DIN, gridDim.x, (int)blockIdx.x);
            pg8::EpiProj E{(bf16*)(ws + WS_PROJ), (const float*)(ws + WS_ROWSS) + l * MROWS, DIN};
            pg8::gemm_phase<pg8::EpiProj, pg8::StaticOrder, true, true>(lds, g, S, E);
        }
#endif
        grid.sync();
#ifndef NO_P2
        for (int T = blockIdx.x; T < NTILES; T += gridDim.x) {
            int tid = threadIdx.x; asm volatile("" : "+v"(tid)); const int lane = tid & 63, wave = __builtin_amdgcn_readfirstlane(tid >> 6);
            unsigned char* ws = KWS; const bf16* proj = (const bf16*)(ws + WS_PROJ); bf16* ybuf = (bf16*)(ws + WS_Y);
#ifndef NO_MC
            { bf16* hloc = (bf16*)(ws + WS_H); float* aggL = (float*)(ws + WS_AGG);
            mixer_c(lds, proj, (const bf16*)(ws + WS_WA) + l * 8 * 4096, (const bf16*)(ws + WS_WX) + l * 8 * 4096, KIN(9) + l * 4 * 512, KIN(10) + l * 512,
                    KIN(12) + l * 512, KIN(14) + l * 512, KIN(15) + l * 512, hloc, hloc + (size_t)MROWS * 512, aggL, aggL + NTILES * 512, T, wave, lane); }
#endif
#ifndef NO_MA
            mixer_a(lds, proj, (const bf16*)(ws + WS_SGUW) + l * 4 * 128 * 128, KIN(3) + l * 256, KIN(5) + l * 512, ybuf, T, tid, wave, lane);
#endif
#ifndef NO_MB
            mixer_b(lds, proj, (const bf16*)(ws + WS_POOLW) + l * 4 * 4096, KIN(7) + l * 256, KIN(8) + l * 256, ybuf, T, tid, wave, lane);
#endif
            __syncthreads();
        }
#endif
        grid.sync();
#ifndef NO_P3
        for (int T = blockIdx.x; T < NTILES; T += gridDim.x) {
            int tid = threadIdx.x; asm volatile("" : "+v"(tid)); unsigned char* ws = KWS; const bf16* hloc = (const bf16*)(ws + WS_H); const float* aggL = (const float*)(ws + WS_AGG);
            p3_tile(lds, (const bf16*)(ws + WS_PROJ), hloc, hloc + (size_t)MROWS * 512, aggL, aggL + NTILES * 512, (bf16*)(ws + WS_Y), T, tid, __builtin_amdgcn_readfirstlane(tid >> 6), tid & 63);
        }
#endif
        grid.sync();
#ifndef NO_P4
        {
            unsigned char* ws = KWS; float* out = KOUT;
            pg8::Gemm g{(const bf16*)(ws + WS_Y), (const bf16*)(ws + WS_WOUT) + (size_t)l * DM * DM, MROWS, DM, DM}; pg8::StaticOrder S; S.init(MROWS, DM, gridDim.x, (int)blockIdx.x);
            pg8::EpiOut E{l == 0 ? KIN(0) : (const float*)out, out, l == 0 ? (bf16*)(ws + WS_H) : (bf16*)nullptr, (float*)(ws + WS_ROWSS) + (l + 1) * MROWS};
            pg8::gemm_phase<pg8::EpiOut, pg8::StaticOrder, true, true>(lds, g, S, E);
        }
#endif
        grid.sync();
    }
    {
        const int tid = threadIdx.x, lane = tid & 63, wave = __builtin_amdgcn_readfirstlane(tid >> 6);
        const int gw = blockIdx.x * NWAVES + wave, NGW = gridDim.x * NWAVES; const float* fg = KIN(18); float* out = KOUT; const float* rowss = (const float*)(KWS + WS_ROWSS) + 2 * MROWS;
        f32x4 gv[4];
#pragma unroll
        for (int j = 0; j < 4; ++j) gv[j] = ((const f32x4*)fg)[64 * j + lane];
        for (int m = gw; m < MROWS; m += NGW) { f32x4* xr = (f32x4*)(out + (size_t)m * DM) + lane; const float rstd = __builtin_amdgcn_rsqf(rowss[m] * (1.0f / 1024.0f) + EPS);
#pragma unroll
            for (int j = 0; j < 4; ++j) { const f32x4 v = xr[64 * j]; xr[64 * j] = v * rstd * gv[j]; } }
    }
}

extern "C" void kernel_launch(void* const* d_in, const int* in_sizes, int n_in, void* d_out, int out_size, void* d_ws, size_t ws_size, hipStream_t stream) {
    static int grid = 0;
    if (grid == 0) {
        int dev = 0, cus = 0, per_cu = 0;
        if (n_in != 19 || out_size != MROWS * DM || ws_size < WS_END) { fprintf(stderr, "kernel_launch: unexpected shapes (n_in %d out %d ws %zu)\n", n_in, out_size, ws_size); grid = -1; return; }
        hipGetDevice(&dev); hipDeviceGetAttribute(&cus, hipDeviceAttributeMultiprocessorCount, dev);
        if (hipFuncSetAttribute((const void*)hybrid_fwd, hipFuncAttributeMaxDynamicSharedMemorySize, LDS_BYTES) != hipSuccess) { fprintf(stderr, "kernel_launch: hipFuncSetAttribute failed\n"); }
        if (hipOccupancyMaxActiveBlocksPerMultiprocessor(&per_cu, (const void*)hybrid_fwd, NTHR, LDS_BYTES) != hipSuccess || per_cu < 1) per_cu = 1;
        (void)hipGetLastError();
        if (per_cu > 1) per_cu = 1;
        grid = cus * per_cu;
        if (grid < 1) grid = 256;
    }
    if (grid < 0) return;
    Params p{};
    for (int i = 0; i < 19; ++i) p.in[i] = (const float*)d_in[i];
    p.out = (float*)d_out; p.ws = (unsigned char*)d_ws;
    void* args[] = {&p};
    hipError_t e = hipLaunchCooperativeKernel((const void*)hybrid_fwd, dim3(grid), dim3(NTHR), args, LDS_BYTES, stream);
    if (e != hipSuccess) fprintf(stderr, "kernel_launch: cooperative launch failed: %s (grid %d)\n", hipGetErrorString(e), grid);
}
```

```cpp
#include <hip/hip_runtime.h>
#include <hip/hip_cooperative_groups.h>
#include <cstdio>
#include <cstdint>
namespace cg = cooperative_groups;
namespace pg8 {
#define PG8_LAS __attribute__((address_space(3)))
typedef unsigned short bf16_t;
typedef short bf16x8 __attribute__((ext_vector_type(8)));
typedef float f32x4 __attribute__((ext_vector_type(4)));
typedef unsigned u32x4 __attribute__((ext_vector_type(4)));
constexpr int BM = 256, BK = 64, HALF = 128, HTB = HALF * BK * 2  , STAGE_BYTES = 8 * HTB, NXCD = 8, WGM = 8;

__host__ __device__ __forceinline__ int lds_byte(int r, int c) { const int st = (r >> 4) * 2 + (c >> 5), rr = r & 15, cc = c & 31, ob = rr * 64 + cc * 2; return st * 1024 + (ob ^ (((ob >> 9) & 1) << 5)); }
__host__ __device__ __forceinline__ void stage_rc(int b, int& R, int& C) { const int st = b / 1024, sb = b % 1024, swz = sb ^ (((sb >> 9) & 1) << 5); R = (st >> 1) * 16 + swz / 64; C = (st & 1) * 32 + (swz % 64) / 2; }
__host__ __device__ __forceinline__ int perm32(int rho) { const int n = rho >> 4, i = rho & 15; return 8 * (i >> 2) + 4 * n + (i & 3); }

struct Unit { int pm, pn; };
struct Gemm { const bf16_t* A; const bf16_t* Bt; int M, N, K; };

struct StaticOrder {
    int nM, nN, nwg, G, c;
    __host__ __device__ void init(int M, int N, int G_, int c_) { nM = M / BM; nN = N / BM; nwg = nM * nN; G = G_; c = c_; }
    __host__ __device__ bool next(int i, Unit& u) const {
        const long L = (long)i * G + c; if (L >= nwg) return false;
        int wgid = (int)L; { const int q = nwg / NXCD, r = nwg % NXCD, xcd = wgid % NXCD, off = wgid / NXCD; wgid = (xcd < r ? xcd * (q + 1) : r * (q + 1) + (xcd - r) * q) + off; }
        const int nig = WGM * nN, gid = wgid / nig, fm = gid * WGM, gsz = (nM - fm) < WGM ? (nM - fm) : WGM;
        u.pm = fm + ((wgid % nig) % gsz); u.pn = (wgid % nig) / gsz; return true;
    }
    __device__ __forceinline__ void a_ready(const Unit&) const {}
    __device__ __forceinline__ void done(const Unit&) const {}
};

__device__ __forceinline__ unsigned cvt_pk_bf16(float lo, float hi) { unsigned r; asm volatile("v_cvt_pk_bf16_f32 %0, %1, %2" : "=v"(r) : "v"(lo), "v"(hi)); return r; }

struct EpiProj {
    static constexpr bool PERM = true, AFTER_DRAIN = false;
    bf16_t* O; const float* rowss; int ldc;
    __device__ __forceinline__ void operator()(const f32x4 (&acc)[2][2][4][2], const Unit& u, int wr, int wc, int fr, int fq) const {
        const int row0 = u.pm * BM + wr * 64 + fr, col0 = u.pn * BM + wc * 32 + 8 * fq;
#pragma unroll
        for (int ai = 0; ai < 2; ++ai)
#pragma unroll
            for (int m = 0; m < 4; ++m) {
                const int row = row0 + ai * HALF + m * 16;
                const float rs = __builtin_amdgcn_rsqf(rowss[row] * (1.0f / 1024.0f) + 1e-6f);
                bf16_t* rowp = O + (size_t)row * ldc + col0;
#pragma unroll
                for (int bj = 0; bj < 2; ++bj) { const f32x4 v0 = acc[ai][bj][m][0] * rs, v1 = acc[ai][bj][m][1] * rs;
                    u32x4 w; w.x = cvt_pk_bf16(v0[0], v0[1]); w.y = cvt_pk_bf16(v0[2], v0[3]); w.z = cvt_pk_bf16(v1[0], v1[1]); w.w = cvt_pk_bf16(v1[2], v1[3]);
                    *(u32x4*)(rowp + bj * HALF) = w; }
            }
    }
};
struct EpiOut {
    static constexpr bool PERM = true, AFTER_DRAIN = false;
    const float* resid; float* out; bf16_t* hb; float* rowss;
    __device__ __forceinline__ void operator()(const f32x4 (&acc)[2][2][4][2], const Unit& u, int wr, int wc, int fr, int fq) const {
        const int row0 = u.pm * BM + wr * 64 + fr, col0 = u.pn * BM + wc * 32 + 8 * fq;
#pragma unroll
        for (int ai = 0; ai < 2; ++ai)
#pragma unroll
            for (int m = 0; m < 4; ++m) {
                const int row = row0 + ai * HALF + m * 16;
                const size_t off = (size_t)row * 1024 + col0;
                float ss = 0.f;
#pragma unroll
                for (int bj = 0; bj < 2; ++bj) {
                    const f32x4 r0 = *(const f32x4*)(resid + off + bj * HALF), r1 = *(const f32x4*)(resid + off + bj * HALF + 4);
                    const f32x4 v0 = acc[ai][bj][m][0] + r0, v1 = acc[ai][bj][m][1] + r1;
                    *(f32x4*)(out + off + bj * HALF) = v0; *(f32x4*)(out + off + bj * HALF + 4) = v1;
                    ss += (v0[0] * v0[0] + v0[1] * v0[1]) + (v0[2] * v0[2] + v0[3] * v0[3]) + (v1[0] * v1[0] + v1[1] * v1[1]) + (v1[2] * v1[2] + v1[3] * v1[3]);
                    if (hb) { u32x4 w; w.x = cvt_pk_bf16(v0[0], v0[1]); w.y = cvt_pk_bf16(v0[2], v0[3]); w.z = cvt_pk_bf16(v1[0], v1[1]); w.w = cvt_pk_bf16(v1[2], v1[3]);
                        *(u32x4*)(hb + off + bj * HALF) = w; }
                }
                ss += __shfl_xor(ss, 16); ss += __shfl_xor(ss, 32);
                if (fq == 0) unsafeAtomicAdd(rowss + row, ss);
            }
    }
};

template <class Epi, class Sched, bool ALIGN_EPI = false, bool SP2 = false>
__device__ __forceinline__ void gemm_phase(PG8_LAS unsigned char* lds, const Gemm g, const Sched& S, const Epi& E) {
    int tid_ = threadIdx.x; asm volatile("" : "+v"(tid_));
    const int tid = tid_, wid = __builtin_amdgcn_readfirstlane(tid >> 6), lane = tid & 63, wr = wid >> 2, wc = wid & 3, fr = lane & 15, fq = lane >> 4;
    const int K = g.K, nt = K / BK;
    unsigned voffA[2], voffB[2];
#pragma unroll
    for (int i = 0; i < 2; ++i) { int R, C; stage_rc(tid * 16 + i * 8192, R, C); const int Rb = Epi::PERM ? ((R & ~31) + perm32(R & 31)) : R;
        voffA[i] = (unsigned)(R * K + C) * 2u; voffB[i] = (unsigned)(Rb * K + C) * 2u; }
    const size_t kstep = (size_t)(BK * 2);
    const size_t hstep = (size_t)HALF * K * 2;
    const size_t tstep = 2 * hstep;
    const unsigned ldsw = (unsigned)wid * 1024u;
    const int aoff = lds_byte(wr * 64 + fr, fq * 8), boff = lds_byte(wc * 32 + fr, fq * 8);
#define PG8_SA(b, h) (((b) * 2 + (h)) * HTB)
#define PG8_SB(b, h) ((4 + (b) * 2 + (h)) * HTB)
#define PG8_STAGE(bufoff, gbase, voff) do { _Pragma("unroll") for (int _i = 0; _i < 2; ++_i) \
        __builtin_amdgcn_global_load_lds((const unsigned*)((const char*)(gbase) + (voff)[_i]), (PG8_LAS unsigned*)(lds + (bufoff) + ldsw + _i * 8192), 16, 0, 0); } while (0)
#define PG8_LDA(dst, b, h) do { _Pragma("unroll") for (int m = 0; m < 4; ++m) _Pragma("unroll") for (int k = 0; k < 2; ++k) dst[m][k] = *(const PG8_LAS bf16x8*)(lds + PG8_SA(b, h) + aoff + m * 2048 + k * 1024); } while (0)
#define PG8_LDB(dst, b, h) do { _Pragma("unroll") for (int n = 0; n < 2; ++n) _Pragma("unroll") for (int k = 0; k < 2; ++k) dst[n][k] = *(const PG8_LAS bf16x8*)(lds + PG8_SB(b, h) + boff + n * 2048 + k * 1024); } while (0)
#define PG8_MMA(ai, bj, At, Bt) do { __builtin_amdgcn_s_setprio(1); _Pragma("unroll") for (int m = 0; m < 4; ++m) _Pragma("unroll") for (int n = 0; n < 2; ++n) _Pragma("unroll") for (int k = 0; k < 2; ++k) \
        acc[ai][bj][m][n] = __builtin_amdgcn_mfma_f32_16x16x32_bf16(Bt[n][k], At[m][k], acc[ai][bj][m][n], 0, 0, 0); __builtin_amdgcn_s_setprio(0); } while (0)
#define PG8_WAIT_V(n) asm volatile("s_waitcnt vmcnt(" #n ")" ::: "memory")
#define PG8_WAIT_L(n) asm volatile("s_waitcnt lgkmcnt(" #n ")" ::: "memory")
#define PG8_BAR __builtin_amdgcn_s_barrier()
#define PG8_SCHED __builtin_amdgcn_sched_barrier(0)
    Unit cur, nxt; int ui = 0;
    if (!S.next(0, cur)) return;
    f32x4 acc[2][2][4][2];
#pragma unroll
    for (int a = 0; a < 2; ++a)
#pragma unroll
        for (int b = 0; b < 2; ++b)
#pragma unroll
            for (int m = 0; m < 4; ++m)
#pragma unroll
                for (int n = 0; n < 2; ++n) acc[a][b][m][n] = (f32x4){0.f, 0.f, 0.f, 0.f};
    bf16x8 At[4][2], B0[2][2], B1[2][2];
    const char* cA = (const char*)g.A + (size_t)cur.pm * tstep; const char* cB = (const char*)g.Bt + (size_t)cur.pn * tstep;
    S.a_ready(cur);
    if constexpr (SP2) {
        PG8_STAGE(PG8_SB(0, 0), cB, voffB); PG8_STAGE(PG8_SB(0, 1), cB + hstep, voffB); PG8_STAGE(PG8_SA(0, 0), cA, voffA); PG8_STAGE(PG8_SA(0, 1), cA + hstep, voffA);
        if (wr == 1) PG8_BAR;
        PG8_WAIT_V(2); PG8_BAR;
        PG8_STAGE(PG8_SB(1, 0), cB + kstep, voffB); PG8_STAGE(PG8_SA(1, 0), cA + kstep, voffA); PG8_STAGE(PG8_SB(1, 1), cB + hstep + kstep, voffB);
        PG8_WAIT_V(6); PG8_BAR;
    } else {
        PG8_STAGE(PG8_SB(0, 0), cB, voffB); PG8_STAGE(PG8_SA(0, 0), cA, voffA); PG8_STAGE(PG8_SB(0, 1), cB + hstep, voffB); PG8_STAGE(PG8_SA(0, 1), cA + hstep, voffA);
        if (wr == 1) PG8_BAR;
        PG8_WAIT_V(4); PG8_BAR;
        PG8_STAGE(PG8_SB(1, 0), cB + kstep, voffB); PG8_STAGE(PG8_SA(1, 0), cA + kstep, voffA); PG8_STAGE(PG8_SB(1, 1), cB + hstep + kstep, voffB);
        PG8_WAIT_V(6); PG8_BAR;
    }
    for (;;) {
        const bool has_next = S.next(ui + 1, nxt);
        const char* nA = has_next ? (const char*)g.A + (size_t)nxt.pm * tstep : cA; const char* nB = has_next ? (const char*)g.Bt + (size_t)nxt.pn * tstep : cB;
        for (int t = 0; t < nt; t += 2) {
            const bool last = (t == nt - 2);
            const char* a1 = cA + (size_t)(t + 1) * kstep;
            const char* a2 = last ? nA : cA + (size_t)(t + 2) * kstep; const char* b2 = last ? nB : cB + (size_t)(t + 2) * kstep;
            const char* a3 = a2 + kstep; const char* b3 = b2 + kstep;
            if (last && has_next) S.a_ready(nxt);
            if constexpr (SP2) {
            PG8_LDB(B0, 0, 0); PG8_LDB(B1, 0, 1); PG8_SCHED; PG8_LDA(At, 0, 0); PG8_STAGE(PG8_SA(1, 1), a1 + hstep, voffA);
            PG8_WAIT_V(8); PG8_WAIT_L(0); PG8_BAR; PG8_MMA(0, 0, At, B0); PG8_MMA(0, 1, At, B1); PG8_BAR; PG8_SCHED;
            PG8_LDA(At, 0, 1); PG8_STAGE(PG8_SB(0, 0), b2, voffB); PG8_STAGE(PG8_SB(0, 1), b2 + hstep, voffB); PG8_STAGE(PG8_SA(0, 0), a2, voffA);
            PG8_WAIT_V(8); PG8_WAIT_L(0); PG8_BAR; PG8_MMA(1, 0, At, B0); PG8_MMA(1, 1, At, B1); PG8_BAR; PG8_SCHED;
            PG8_LDB(B0, 1, 0); PG8_LDB(B1, 1, 1); PG8_SCHED; PG8_LDA(At, 1, 0); PG8_STAGE(PG8_SA(0, 1), a2 + hstep, voffA);
            PG8_WAIT_V(8); PG8_WAIT_L(0); PG8_BAR; PG8_MMA(0, 0, At, B0); PG8_MMA(0, 1, At, B1); PG8_BAR; PG8_SCHED;
            PG8_LDA(At, 1, 1); PG8_STAGE(PG8_SB(1, 0), b3, voffB); PG8_STAGE(PG8_SB(1, 1), b3 + hstep, voffB); PG8_STAGE(PG8_SA(1, 0), a3, voffA);
            PG8_WAIT_V(8); PG8_WAIT_L(0); PG8_BAR; PG8_MMA(1, 0, At, B0); PG8_MMA(1, 1, At, B1); PG8_BAR; PG8_SCHED;
            } else {
            PG8_LDB(B0, 0, 0); PG8_SCHED; PG8_LDA(At, 0, 0); PG8_STAGE(PG8_SA(1, 1), a1 + hstep, voffA);
            PG8_WAIT_L(8); PG8_BAR; PG8_WAIT_L(0); PG8_MMA(0, 0, At, B0); PG8_BAR; PG8_SCHED;
            PG8_LDB(B1, 0, 1); PG8_STAGE(PG8_SB(0, 0), b2, voffB);
            PG8_BAR; PG8_WAIT_L(0); PG8_MMA(0, 1, At, B1); PG8_BAR;
            PG8_LDA(At, 0, 1); PG8_STAGE(PG8_SA(0, 0), a2, voffA);
            PG8_BAR; PG8_WAIT_L(0); PG8_MMA(1, 0, At, B0); PG8_BAR; PG8_SCHED;
            PG8_STAGE(PG8_SB(0, 1), b2 + hstep, voffB);
            PG8_WAIT_V(6); PG8_BAR; PG8_MMA(1, 1, At, B1); PG8_BAR;
            PG8_LDB(B0, 1, 0); PG8_SCHED; PG8_LDA(At, 1, 0); PG8_STAGE(PG8_SA(0, 1), a2 + hstep, voffA);
            PG8_WAIT_L(8); PG8_BAR; PG8_WAIT_L(0); PG8_MMA(0, 0, At, B0); PG8_BAR; PG8_SCHED;
            PG8_LDB(B1, 1, 1); PG8_STAGE(PG8_SB(1, 0), b3, voffB);
            PG8_BAR; PG8_WAIT_L(0); PG8_MMA(0, 1, At, B1); PG8_BAR;
            PG8_LDA(At, 1, 1); PG8_STAGE(PG8_SA(1, 0), a3, voffA);
            PG8_BAR; PG8_WAIT_L(0); PG8_MMA(1, 0, At, B0); PG8_BAR; PG8_SCHED;
            PG8_STAGE(PG8_SB(1, 1), b3 + hstep, voffB);
            PG8_WAIT_V(6); PG8_BAR; PG8_MMA(1, 1, At, B1); PG8_BAR;
            }
        }
        if constexpr (ALIGN_EPI) { if (wr == 0) PG8_BAR; }
        if constexpr (!Epi::AFTER_DRAIN) { E(acc, cur, wr, wc, fr, fq); S.done(cur); }
        if (!has_next) break;
#pragma unroll
        for (int a = 0; a < 2; ++a)
#pragma unroll
            for (int b = 0; b < 2; ++b)
#pragma unroll
                for (int m = 0; m < 4; ++m)
#pragma unroll
                    for (int n = 0; n < 2; ++n) acc[a][b][m][n] = (f32x4){0.f, 0.f, 0.f, 0.f};
        cur = nxt; cA = nA; cB = nB; ++ui;
        if constexpr (ALIGN_EPI) { if (wr == 1) PG8_BAR; }
    }
    PG8_WAIT_V(0);
    if constexpr (!ALIGN_EPI) { if (wr == 0) PG8_BAR; }
    PG8_BAR;
    if constexpr (Epi::AFTER_DRAIN) { E.fused(acc, cur, wr, wc, fr, fq, lds, wid, lane); S.done(cur); }
#undef PG8_SA
#undef PG8_SB
#undef PG8_STAGE
#undef PG8_LDA
#undef PG8_LDB
#undef PG8_MMA
#undef PG8_WAIT_V
#undef PG8_WAIT_L
#undef PG8_BAR
#undef PG8_SCHED
}
}

constexpr int NWAVES = 8, NTHR = 512;
constexpr int MROWS = 32768, DM = 1024, DIN = 2304, SEQ = 4096, TILE = 128, NTILES = MROWS / TILE, TPS = SEQ / TILE;
constexpr int OFF_AU = 0, OFF_AV = 256, OFF_AZ = 512, OFF_BX = 768, OFF_BZ = 1024, OFF_CX = 1280, OFF_CZ = 1792;
constexpr float EPS = 1e-6f;
constexpr size_t MiB = 1u << 20;
constexpr size_t WS_WIN = 0;
constexpr size_t WS_WOUT = 9 * MiB;
constexpr size_t WS_SGUW = 13 * MiB;
constexpr size_t WS_POOLW = 13 * MiB + 256 * 1024;
constexpr size_t WS_WA = 13 * MiB + 512 * 1024;
constexpr size_t WS_WX = 13 * MiB + 768 * 1024;
constexpr size_t WS_ROWSS = 14 * MiB;
constexpr size_t WS_CTL = 14 * MiB + 512 * 1024, CTL_BYTES = 16384;
constexpr size_t WS_AGG = 15 * MiB;
constexpr size_t WS_H = 16 * MiB;
constexpr size_t WS_PROJ = 80 * MiB;
constexpr size_t WS_Y = 224 * MiB;
constexpr size_t WS_END = 288 * MiB;
constexpr int LDS_BYTES = 147456;

#define LAS __attribute__((address_space(3)))
typedef unsigned short bf16;
typedef unsigned v4u __attribute__((ext_vector_type(4)));
typedef unsigned v2u __attribute__((ext_vector_type(2)));
typedef float f32x4 __attribute__((ext_vector_type(4)));
typedef short bf16x8 __attribute__((ext_vector_type(8)));

__device__ __forceinline__ unsigned pk2(float lo, float hi) { return pg8::cvt_pk_bf16(lo, hi); }
__device__ __forceinline__ float bflo(unsigned w) { return __uint_as_float(w << 16); }
__device__ __forceinline__ float bfhi(unsigned w) { return __uint_as_float(w & 0xffff0000u); }
__device__ __forceinline__ float bf2f(bf16 b) { return __uint_as_float(((unsigned)b) << 16); }
__device__ __forceinline__ bf16 f2bf(float f) { return (bf16)(pk2(f, 0.f) & 0xffffu); }
__device__ __forceinline__ float fexp(float x) { return __builtin_amdgcn_exp2f(x * 1.4426950408889634f); }
__device__ __forceinline__ float sigm(float x) { return __builtin_amdgcn_rcpf(1.0f + fexp(-x)); }
__device__ __forceinline__ float silu(float x) { return x * sigm(x); }
__device__ __forceinline__ float wave_sum(float v) {
#pragma unroll
    for (int o = 1; o < 64; o <<= 1) v += __shfl_xor(v, o);
    return v;
}
__device__ __forceinline__ void unpack8(const v4u w, float (&x)[8]) {
    x[0] = bflo(w.x); x[1] = bfhi(w.x); x[2] = bflo(w.y); x[3] = bfhi(w.y); x[4] = bflo(w.z); x[5] = bfhi(w.z); x[6] = bflo(w.w); x[7] = bfhi(w.w);
}
__device__ __forceinline__ v4u pack8(const float (&x)[8]) { v4u w; w.x = pk2(x[0], x[1]); w.y = pk2(x[2], x[3]); w.z = pk2(x[4], x[5]); w.w = pk2(x[6], x[7]); return w; }
#define MFMA16(a, b, c) __builtin_amdgcn_mfma_f32_16x16x32_bf16((a), (b), (c), 0, 0, 0)

struct Params {
    const float* in[19];
    float* out; unsigned char* ws;
};

__device__ __forceinline__ void p0_transpose_item(const float* W, const float* gk, int K, int N, bf16* WT, LAS float* scr, int item, int lane) {
    const int nblk = N / 32, kb = item / nblk, nb = item % nblk, k0 = 64 * kb, n0 = 32 * nb;
#pragma unroll 8
    for (int i = 0; i < 32; ++i) { const int kk = 2 * i + (lane >> 5); scr[kk * 33 + (lane & 31)] = W[(size_t)(k0 + kk) * N + n0 + (lane & 31)] * gk[k0 + kk]; }
    asm volatile("s_waitcnt lgkmcnt(0)" ::: "memory");
    const int c = lane & 7;
#pragma unroll
    for (int j = 0; j < 4; ++j) { const int n = (lane >> 3) + 8 * j; const LAS float* s = scr + (8 * c) * 33 + n;
        v4u o; o.x = pk2(s[0 * 33], s[1 * 33]); o.y = pk2(s[2 * 33], s[3 * 33]); o.z = pk2(s[4 * 33], s[5 * 33]); o.w = pk2(s[6 * 33], s[7 * 33]);
        *(v4u*)(WT + (size_t)(n0 + n) * K + k0 + 8 * c) = o; }
    asm volatile("s_waitcnt lgkmcnt(0)" ::: "memory");
}
__device__ __forceinline__ void p0_prologue(const Params& p, LAS unsigned char* lds, int tid, int lane, int wave) {
    unsigned char* ws = p.ws;
    LAS float* scr = (LAS float*)(lds + wave * 16384);
    const int G = gridDim.x, gw = blockIdx.x * NWAVES + wave, NGW = G * NWAVES;
    constexpr int I_IN = (DM / 64) * (DIN / 32), I_OUT = (DM / 64) * (DM / 32);
    for (int it = gw; it < 2 * (I_IN + I_OUT); it += NGW) {
        int r = it;
        if (r < 2 * I_IN) { const int l = r / I_IN; r -= l * I_IN;
            p0_transpose_item(p.in[2] + (size_t)l * DM * DIN, p.in[1] + l * DM, DM, DIN, (bf16*)(ws + WS_WIN) + (size_t)l * DIN * DM, scr, r, lane); continue; }
        r -= 2 * I_IN; { const int l = r / I_OUT; r -= l * I_OUT;
            p0_transpose_item(p.in[17] + (size_t)l * DM * DM, p.in[16] + l * DM, DM, DM, (bf16*)(ws + WS_WOUT) + (size_t)l * DM * DM, scr, r, lane); }
    }
    const int gt = blockIdx.x * NTHR + tid, NGT = G * NTHR;
    for (int i = gt; i < 2 * 4 * 128 * 128; i += NGT) { const int jj = i & 127, ii = (i >> 7) & 127; const float m = ((jj >> 6) <= (ii >> 6)) ? 1.f : 0.f; ((bf16*)(ws + WS_SGUW))[i] = f2bf(p.in[4][i] * m); }
    for (int i = gt; i < 2 * 4 * 64 * 64; i += NGT) { const int ii = i & 63, o = (i >> 6) & 63, lg = i >> 12; ((bf16*)(ws + WS_POOLW))[i] = f2bf(p.in[6][(lg * 64 + ii) * 64 + o]); }
    for (int i = gt; i < 2 * 8 * 64 * 64; i += NGT) { const int ii = i & 63, o = (i >> 6) & 63, lh = i >> 12;
        ((bf16*)(ws + WS_WA))[i] = f2bf(p.in[11][(lh * 64 + ii) * 64 + o]); ((bf16*)(ws + WS_WX))[i] = f2bf(p.in[13][(lh * 64 + ii) * 64 + o]); }
    float* rowss = (float*)(ws + WS_ROWSS);
    for (int i = gt; i < 2 * MROWS; i += NGT) rowss[MROWS + i] = 0.f;
    const float* x = p.in[0]; bf16* hb = (bf16*)(ws + WS_H);
    for (int m = gw; m < MROWS; m += NGW) {
        const f32x4* xr = (const f32x4*)(x + (size_t)m * DM) + lane; float s = 0.f;
        unsigned long long* o8 = (unsigned long long*)(hb + (size_t)m * DM) + lane;
#pragma unroll
        for (int j = 0; j < 4; ++j) { const f32x4 v = xr[64 * j]; s += (v.x * v.x + v.y * v.y) + (v.z * v.z + v.w * v.w);
            o8[64 * j] = (unsigned long long)pk2(v.x, v.y) | ((unsigned long long)pk2(v.z, v.w) << 32); }
        s = wave_sum(s);
        if (lane == 0) rowss[m] = s;
    }
}

constexpr int L_YT = 73728, L_RSTDV = L_YT + 67584, L_HIN = 0, L_MISC = LDS_BYTES - 64;

__device__ __forceinline__ void mixer_c(LAS unsigned char* lds, const bf16* proj, const bf16* waT, const bf16* wxT, const float* conv_w, const float* conv_b,
                                        const float* lba, const float* lbx, const float* lam, bf16* hloc, bf16* Lbuf, float* aggL, float* aggH, int T, int wid, int lane) {
    const int h = wid, g = lane >> 4, o = lane & 15, tt = T % TPS;
    const size_t R0 = (size_t)T * TILE;
    LAS unsigned char* cimg = lds + wid * 9216;
    bf16x8 WA[4][2], WX[4][2];
#pragma unroll
    for (int n = 0; n < 4; ++n)
#pragma unroll
        for (int kk = 0; kk < 2; ++kk) { const int idx = (h * 64 + 16 * n + o) * 64 + 32 * kk + 8 * g; WA[n][kk] = *(const bf16x8*)(waT + idx); WX[n][kk] = *(const bf16x8*)(wxT + idx); }
    float pba[4], pbx[4], psp[4], hc[4], Lc[4];
#pragma unroll
    for (int n = 0; n < 4; ++n) { const int c = 64 * h + 16 * n + o; pba[n] = lba[c]; pbx[n] = lbx[c];
        const float xm = -lam[c]; psp[n] = -8.0f * (fmaxf(xm, 0.f) + log1pf(expf(-fabsf(xm)))); hc[n] = 0.f; Lc[n] = 0.f; }
#pragma unroll 1
    for (int half = 0; half < 2; ++half) {
        {
            const int oc = lane & 15, seg = lane >> 4, cc = 64 * h + 4 * oc;
            f32x4 cw0 = *(const f32x4*)(conv_w + cc), cw1 = *(const f32x4*)(conv_w + 512 + cc), cw2 = *(const f32x4*)(conv_w + 1024 + cc), cw3 = *(const f32x4*)(conv_w + 1536 + cc), cb = *(const f32x4*)(conv_b + cc);
            const int t0 = 64 * half + 16 * seg;
            const bf16* base = proj + (R0 + t0) * DIN + OFF_CX + cc;
            f32x4 x0 = {0.f, 0.f, 0.f, 0.f}, x1 = x0, x2 = x0;
            const bool pv = (t0 > 0) || (tt > 0);
            if (pv) { v2u w; w = *(const v2u*)(base - 3 * DIN); x0 = (f32x4){bflo(w.x), bfhi(w.x), bflo(w.y), bfhi(w.y)};
                w = *(const v2u*)(base - 2 * DIN); x1 = (f32x4){bflo(w.x), bfhi(w.x), bflo(w.y), bfhi(w.y)};
                w = *(const v2u*)(base - 1 * DIN); x2 = (f32x4){bflo(w.x), bfhi(w.x), bflo(w.y), bfhi(w.y)}; }
#pragma unroll 4
            for (int r = 0; r < 16; ++r) {
                const v2u w = *(const v2u*)(base + r * DIN); const f32x4 cur = {bflo(w.x), bfhi(w.x), bflo(w.y), bfhi(w.y)};
                const f32x4 cv = cb + cw0 * x0 + cw1 * x1 + cw2 * x2 + cw3 * cur; x0 = x1; x1 = x2; x2 = cur;
                v2u ov; ov.x = pk2(cv.x, cv.y); ov.y = pk2(cv.z, cv.w);
                *(LAS v2u*)(cimg + (16 * seg + r) * 144 + oc * 8) = ov;
            }
        }
        asm volatile("s_waitcnt lgkmcnt(0)" ::: "memory");
#pragma unroll 1
        for (int mm = 0; mm < 4; ++mm) {
            const int m = 4 * half + mm;
            bf16x8 XA[2];
#pragma unroll
            for (int kk = 0; kk < 2; ++kk) XA[kk] = *(const LAS bf16x8*)(cimg + (16 * mm + o) * 144 + (32 * kk + 8 * g) * 2);
#pragma unroll
            for (int n = 0; n < 4; ++n) {
                f32x4 Da = {0.f, 0.f, 0.f, 0.f}, Dx = {0.f, 0.f, 0.f, 0.f};
                Da = MFMA16(XA[0], WA[n][0], Da); Da = MFMA16(XA[1], WA[n][1], Da);
                Dx = MFMA16(XA[0], WX[n][0], Dx); Dx = MFMA16(XA[1], WX[n][1], Dx);
                float Hr[4], Lr[4], Hrun = 0.f, Lrun = 0.f;
#pragma unroll
                for (int reg = 0; reg < 4; ++reg) {
                    const float cv = bf2f(*(const LAS bf16*)(cimg + (16 * mm + 4 * g + reg) * 144 + (16 * n + o) * 2));
                    const float r = sigm(Da[reg] + pba[n]), ig = sigm(Dx[reg] + pbx[n]);
                    const float la = psp[n] * r, a = fexp(la), x2v = 2.0f * la;
                    const float ser = -x2v * (1.0f + x2v * (0.5f + x2v * (0.16666667f + x2v * (0.041666668f + x2v * 0.0083333338f))));
                    const float em = (x2v > -0.25f) ? ser : (1.0f - fexp(x2v));
                    const float b = __builtin_amdgcn_sqrtf(em) * ig * cv;
                    Hrun = a * Hrun + b; Lrun += la; Hr[reg] = Hrun; Lr[reg] = Lrun;
                }
                float Lt = Lrun, Ht = Hrun;
                { const float Lp = __shfl_up(Lt, 16), Hp = __shfl_up(Ht, 16); if (g >= 1) { Ht = fexp(Lt) * Hp + Ht; Lt = Lp + Lt; } }
                { const float Lp = __shfl_up(Lt, 32), Hp = __shfl_up(Ht, 32); if (g >= 2) { Ht = fexp(Lt) * Hp + Ht; Lt = Lp + Lt; } }
                float Le = __shfl_up(Lt, 16), He = __shfl_up(Ht, 16); if (g == 0) { Le = 0.f; He = 0.f; }
                const float Hpre = fexp(Le) * hc[n] + He, Lpre = Lc[n] + Le;
                float hv = 0.f, lv = 0.f;
                const size_t so = (R0 + 16 * m + 4 * g) * 512 + 64 * h + 16 * n + o;
#pragma unroll
                for (int reg = 0; reg < 4; ++reg) { hv = Hr[reg] + fexp(Lr[reg]) * Hpre; lv = Lr[reg] + Lpre; hloc[so + reg * 512] = f2bf(hv); Lbuf[so + reg * 512] = f2bf(lv); }
                hc[n] = __shfl(hv, 48 + o); Lc[n] = __shfl(lv, 48 + o);
            }
        }
    }
    if (g == 0) {
#pragma unroll
        for (int n = 0; n < 4; ++n) { const int c = 64 * h + 16 * n + o; aggL[(size_t)T * 512 + c] = Lc[n]; aggH[(size_t)T * 512 + c] = hc[n]; } }
}

__device__ __forceinline__ void finish_rows(LAS unsigned char* ytile, const bf16* mulp, const bf16* zp, bf16* outp, int tid) {
    const int c8 = 8 * (tid & 31), tb = tid >> 5;
#pragma unroll 2
    for (int i = 0; i < 8; ++i) { const int t = tb + 16 * i;
        float y[8], z[8]; unpack8(*(const LAS v4u*)(ytile + t * 528 + c8 * 2), y); unpack8(*(const v4u*)(zp + (size_t)t * DIN + c8), z);
        if (mulp) { float u[8]; unpack8(*(const v4u*)(mulp + (size_t)t * DIN + c8), u);
#pragma unroll
            for (int e = 0; e < 8; ++e) y[e] *= u[e]; }
        float ss = 0.f;
#pragma unroll
        for (int e = 0; e < 8; ++e) ss += y[e] * y[e];
        ss += __shfl_xor(ss, 1); ss += __shfl_xor(ss, 2); ss += __shfl_xor(ss, 4); ss += __shfl_xor(ss, 8); ss += __shfl_xor(ss, 16);
        const float rstd = __builtin_amdgcn_rsqf(ss * (1.0f / 256.0f) + EPS);
#pragma unroll
        for (int e = 0; e < 8; ++e) y[e] = y[e] * rstd * silu(z[e]);
        *(v4u*)(outp + (size_t)t * DM + c8) = pack8(y); }
}

__device__ __forceinline__ void mixer_a(LAS unsigned char* lds, const bf16* proj, const bf16* sguW, const float* sgu_g, const float* sgu_b, bf16* ybuf, int T, int tid, int wid, int lane) {
    const int g = lane >> 4, o = lane & 15;
    const size_t R0 = (size_t)T * TILE;
    LAS float* rstdv = (LAS float*)(lds + L_RSTDV); LAS unsigned char* ytile = lds + L_YT;
#pragma unroll 4
    for (int rr = 0; rr < 16; ++rr) { const int j = 16 * wid + rr; const v2u w = *(const v2u*)(proj + (R0 + j) * DIN + OFF_AV + 4 * lane);
        const float a = bflo(w.x), b = bfhi(w.x), c = bflo(w.y), d = bfhi(w.y); const float s = wave_sum((a * a + b * b) + (c * c + d * d));
        if (lane == 0) rstdv[j] = __builtin_amdgcn_rsqf(s * (1.0f / 256.0f) + EPS); }
    __syncthreads();
    { const int jo = tid & 15, co = tid >> 4;
        float sg[8]; { const f32x4 a = *(const f32x4*)(sgu_g + 8 * co), b = *(const f32x4*)(sgu_g + 8 * co + 4); sg[0] = a.x; sg[1] = a.y; sg[2] = a.z; sg[3] = a.w; sg[4] = b.x; sg[5] = b.y; sg[6] = b.z; sg[7] = b.w; }
        v4u rows[8]; float rs[8];
#pragma unroll
        for (int r = 0; r < 8; ++r) { rows[r] = *(const v4u*)(proj + (R0 + 8 * jo + r) * DIN + OFF_AV + 8 * co); rs[r] = rstdv[8 * jo + r]; }
#pragma unroll
        for (int e = 0; e < 8; ++e) { float v[8];
#pragma unroll
            for (int r = 0; r < 8; ++r) { const unsigned w = rows[r][e >> 1]; v[r] = ((e & 1) ? bfhi(w) : bflo(w)) * rs[r] * sg[e]; }
            *(LAS v4u*)(lds + (8 * co + e) * 272 + 16 * jo) = pack8(v); }
    }
    __syncthreads();
    const int h = wid & 3, hf = wid >> 2;
#pragma unroll 1
    for (int m = 0; m < 4; ++m) {
        f32x4 D[4];
#pragma unroll
        for (int n = 0; n < 4; ++n) D[n] = (f32x4){0.f, 0.f, 0.f, 0.f};
        const bf16* xw = sguW + ((h * 128 + 64 * hf + 16 * m + o) * 128 + 8 * g);
#pragma unroll
        for (int kk = 0; kk < 4; ++kk) if (kk < 2 || hf) {
            const bf16x8 X = *(const bf16x8*)(xw + 32 * kk);
#pragma unroll
            for (int n = 0; n < 4; ++n) { const bf16x8 Y = *(const LAS bf16x8*)(lds + (64 * h + 16 * n + o) * 272 + (32 * kk + 8 * g) * 2); D[n] = MFMA16(X, Y, D[n]); }
        }
        const int tb = 64 * hf + 16 * m + 4 * g;
        const f32x4 bias = *(const f32x4*)(sgu_b + h * 128 + tb);
#pragma unroll
        for (int reg = 0; reg < 4; ++reg)
#pragma unroll
            for (int n = 0; n < 4; ++n) *(LAS bf16*)(ytile + (tb + reg) * 528 + (64 * h + 16 * n + o) * 2) = f2bf(D[n][reg] + bias[reg]);
    }
    __syncthreads();
    finish_rows(ytile, proj + R0 * DIN + OFF_AU, proj + R0 * DIN + OFF_AZ, ybuf + R0 * DM, tid);
}

__device__ __forceinline__ void mixer_b(LAS unsigned char* lds, const bf16* proj, const bf16* poolWT, const float* pool_b, const float* pool_s, bf16* ybuf, int T, int tid, int wid, int lane) {
    const int g = lane >> 4, o = lane & 15, tt = T % TPS;
    const size_t R0 = (size_t)T * TILE;
    LAS unsigned char* ytile = lds + L_YT;
    {
        const int oc = tid & 31, seg = tid >> 5, grp = oc >> 3, win = 2 << grp, t0 = 8 * seg;
        const bf16* base = proj + R0 * DIN + OFF_BX + 8 * oc;
        float S[8];
#pragma unroll
        for (int e = 0; e < 8; ++e) S[e] = 0.f;
#pragma unroll 1
        for (int k = 1; k < win; ++k) { const int t = t0 - k; if (t >= 0 || tt > 0) { float x[8]; unpack8(*(const v4u*)(base + (long)t * DIN), x);
#pragma unroll
                for (int e = 0; e < 8; ++e) S[e] += x[e]; } }
        const int pos0 = tt * TILE + t0;
#pragma unroll 1
        for (int r = 0; r < 8; ++r) { const int t = t0 + r; float cur[8], pv[8]; unpack8(*(const v4u*)(base + (long)t * DIN), cur);
            const int cnt = min(pos0 + r + 1, win); const float inv = 1.0f / (float)cnt;
#pragma unroll
            for (int e = 0; e < 8; ++e) { S[e] += cur[e]; pv[e] = S[e] * inv - cur[e]; }
            *(LAS v4u*)(lds + t * 528 + oc * 16) = pack8(pv);
            const int told = t - win + 1;
            if (told >= 0 || tt > 0) { float x[8]; unpack8(*(const v4u*)(base + (long)told * DIN), x);
#pragma unroll
                for (int e = 0; e < 8; ++e) S[e] -= x[e]; }
        }
    }
    __syncthreads();
    const int gg = wid & 3, hf = wid >> 2;
    bf16x8 Y[4][2]; float pb[4], ps[4];
#pragma unroll
    for (int n = 0; n < 4; ++n) { const int c = 64 * gg + 16 * n + o; pb[n] = pool_b[c]; ps[n] = pool_s[c];
#pragma unroll
        for (int kk = 0; kk < 2; ++kk) Y[n][kk] = *(const bf16x8*)(poolWT + ((gg * 64 + 16 * n + o) * 64 + 32 * kk + 8 * g)); }
#pragma unroll 1
    for (int m = 0; m < 4; ++m) {
        f32x4 D[4];
#pragma unroll
        for (int n = 0; n < 4; ++n) D[n] = (f32x4){0.f, 0.f, 0.f, 0.f};
#pragma unroll
        for (int kk = 0; kk < 2; ++kk) { const bf16x8 X = *(const LAS bf16x8*)(lds + (64 * hf + 16 * m + o) * 528 + (64 * gg + 32 * kk + 8 * g) * 2);
#pragma unroll
            for (int n = 0; n < 4; ++n) D[n] = MFMA16(X, Y[n][kk], D[n]); }
        const int tb = 64 * hf + 16 * m + 4 * g;
#pragma unroll
        for (int reg = 0; reg < 4; ++reg)
#pragma unroll
            for (int n = 0; n < 4; ++n) *(LAS bf16*)(ytile + (tb + reg) * 528 + (64 * gg + 16 * n + o) * 2) = f2bf((D[n][reg] + pb[n]) * ps[n]);
    }
    __syncthreads();
    finish_rows(ytile, (const bf16*)nullptr, proj + R0 * DIN + OFF_BZ, ybuf + R0 * DM + 256, tid);
}

__device__ __forceinline__ void p3_tile(LAS unsigned char* lds, const bf16* proj, const bf16* hloc, const bf16* Lbuf, const float* aggL, const float* aggH, bf16* ybuf, int T, int tid, int wid, int lane) {
    const int tt = T % TPS; const size_t R0 = (size_t)T * TILE;
    LAS float* hin = (LAS float*)(lds + L_HIN);
    { float hcar = 0.f; const int Tb = T - tt;
        for (int j = 0; j < tt; ++j) { const float L = aggL[(size_t)(Tb + j) * 512 + tid], H = aggH[(size_t)(Tb + j) * 512 + tid]; hcar = fexp(L) * hcar + H; }
        hin[tid] = hcar; }
    __syncthreads();
    float hi[8];
#pragma unroll
    for (int e = 0; e < 8; ++e) hi[e] = hin[8 * lane + e];
#pragma unroll 2
    for (int rr = 0; rr < 16; ++rr) { const int t = wid + 8 * rr; const size_t row = R0 + t;
        float hl[8], L[8], z[8], hv[8];
        unpack8(*(const v4u*)(hloc + row * 512 + 8 * lane), hl); unpack8(*(const v4u*)(Lbuf + row * 512 + 8 * lane), L); unpack8(*(const v4u*)(proj + row * DIN + OFF_CZ + 8 * lane), z);
        float ss = 0.f;
#pragma unroll
        for (int e = 0; e < 8; ++e) { hv[e] = hl[e] + fexp(L[e]) * hi[e]; ss += hv[e] * hv[e]; }
        ss = wave_sum(ss); const float rstd = __builtin_amdgcn_rsqf(ss * (1.0f / 512.0f) + EPS);
#pragma unroll
        for (int e = 0; e < 8; ++e) hv[e] = hv[e] * rstd * silu(z[e]);
        *(v4u*)(ybuf + row * DM + 512 + 8 * lane) = pack8(hv);
    }
    __syncthreads();
}

#define XB_TMO      128
#define XB_XCNT(j)  (256  + 64 * (j))
#define XB_XSUB(j)  (1280 + 64 * (j))
#define XB_XGEN(j)  (2304 + 64 * (j))
#define XB_TOP      3328
#define XB_TOPGEN   3392
#define XCD_BAR_WORDS 3456
#define XB_SPIN_CAP (1u << 18)

__device__ __forceinline__ unsigned xb_ld(unsigned* p)              { return __hip_atomic_load(p, __ATOMIC_RELAXED, __HIP_MEMORY_SCOPE_AGENT); }
__device__ __forceinline__ unsigned xb_add(unsigned* p, unsigned v) { return __hip_atomic_fetch_add(p, v, __ATOMIC_RELAXED, __HIP_MEMORY_SCOPE_AGENT); }
__device__ __forceinline__ unsigned xb_xcc_id() { return (unsigned)__builtin_amdgcn_s_getreg((3 << 11) | 20) & 0xFu; }
#define XB_SPIN(cond, bar) do { unsigned _sp = 0; while (cond) { __builtin_amdgcn_s_sleep(1); \
    if ((++_sp & 255u) == 0u) { if (xb_ld(&(bar)[XB_TMO])) break; if (_sp > XB_SPIN_CAP) { atomicAdd(&(bar)[XB_TMO], 1u); break; } } } } while (0)

struct XcdBarrier {
    unsigned* bar; unsigned x;
    volatile LAS unsigned* st;
};

__device__ __forceinline__ XcdBarrier xcd_barrier_post(unsigned* bar, volatile LAS unsigned* st) {
    XcdBarrier b; b.bar = bar; b.x = xb_xcc_id(); b.st = st;
    if (threadIdx.x == 0) (void)xb_add(&bar[XB_XCNT(b.x)], 1u);
    return b;
}
__device__ __forceinline__ void xcd_barrier_complete(unsigned* bar, unsigned x, unsigned& nloc, unsigned& nx) {
    const unsigned G = gridDim.x * gridDim.y * gridDim.z;
    unsigned sum, cnt, mine, sp = 0u;
    for (;;) {
        sum = 0u; cnt = 0u; mine = 0u;
#pragma unroll
        for (unsigned j = 0; j < 16; ++j) { const unsigned c = xb_ld(&bar[XB_XCNT(j)]); sum += c; cnt += (c > 0u) ? 1u : 0u; mine = (j == x) ? c : mine; }
        if (sum == G) break;
        __builtin_amdgcn_s_sleep(1);
        if ((++sp & 255u) == 0u) { if (xb_ld(&bar[XB_TMO])) break; if (sp > XB_SPIN_CAP) { atomicAdd(&bar[XB_TMO], 1u); break; } }
    }
    nloc = mine > 0u ? mine : 1u; nx = cnt > 0u ? cnt : 1u;
}

__device__ __forceinline__ void xcd_barrier(const XcdBarrier& b) {
    asm volatile("s_waitcnt vmcnt(0)" ::: "memory");
    __syncthreads();
    if (threadIdx.x == 0) {
        unsigned* bar = b.bar;
        __builtin_amdgcn_s_waitcnt(0);
        unsigned nloc = b.st[0], nx = b.st[1];
        if (nloc == 0u) { xcd_barrier_complete(bar, b.x, nloc, nx); b.st[0] = nloc; b.st[1] = nx; }
        const unsigned old = xb_add(&bar[XB_XSUB(b.x)], 1u);
        const unsigned gen = old / nloc;
        if (old + 1u == (gen + 1u) * nloc) {
            __builtin_amdgcn_fence(__ATOMIC_RELEASE, "agent");
            asm volatile("s_waitcnt vmcnt(0)" ::: "memory");
            const unsigned og = xb_add(&bar[XB_TOP], 1u);
            const unsigned tg = og / nx;
            if (og + 1u == (tg + 1u) * nx) xb_add(&bar[XB_TOPGEN], 1u);
            else XB_SPIN(xb_ld(&bar[XB_TOPGEN]) == tg, bar);
            __builtin_amdgcn_fence(__ATOMIC_ACQUIRE, "agent");
            xb_add(&bar[XB_XGEN(b.x)], 1u);
            asm volatile("s_waitcnt vmcnt(0)" ::: "memory");
        } else {
            XB_SPIN(xb_ld(&bar[XB_XGEN(b.x)]) == gen, bar);
            __builtin_amdgcn_fence(__ATOMIC_ACQUIRE, "agent");
            asm volatile("s_waitcnt vmcnt(0)" ::: "memory");
        }
    }
    __syncthreads();
}

#ifndef REP_P0
#define REP_P0 1
#endif
#ifndef REP_P1
#define REP_P1 1
#endif
#ifndef REP_P2
#define REP_P2 1
#endif
#ifndef REP_P3
#define REP_P3 1
#endif
typedef __attribute__((address_space(4))) const unsigned long long* kptr_t;
__device__ __forceinline__ unsigned long long karg(int i) { kptr_t k = (kptr_t)__builtin_amdgcn_kernarg_segment_ptr(); asm volatile("" : "+s"(k)); return k[i]; }
#define KIN(i) ((const float*)karg(i))
#define KOUT ((float*)karg(19))
#define KWS ((unsigned char*)karg(20))

__global__ void __launch_bounds__(NTHR, 2) hybrid_fwd(Params p) {
    extern __shared__ __attribute__((aligned(16))) unsigned char lds_raw[];
    cg::grid_group grid = cg::this_grid();
    LAS unsigned char* lds = (LAS unsigned char*)lds_raw;
    if (threadIdx.x < 16) ((LAS unsigned*)(lds + L_MISC))[threadIdx.x] = 0u;
    __syncthreads();
    const XcdBarrier bar = xcd_barrier_post((unsigned*)(KWS + WS_CTL), (volatile LAS unsigned*)(lds + L_MISC));
    if (gridDim.x == 0x7fffffffu) grid.sync();
#define GRID_BAR() xcd_barrier(bar)
#ifndef NO_P0
    for (int rep0 = 0; rep0 < REP_P0; ++rep0)
    { int tid = threadIdx.x; asm volatile("" : "+v"(tid)); p0_prologue(p, lds, tid, tid & 63, __builtin_amdgcn_readfirstlane(tid >> 6)); }
#endif
    GRID_BAR();
#pragma unroll 1
    for (int l = 0; l < 2; ++l) {
#ifndef NO_P1
        for (int rep1 = 0; rep1 < REP_P1; ++rep1)
        {
            unsigned char* ws = KWS;
            pg8::Gemm g{(const bf16*)(ws + WS_H), (const bf16*)(ws + WS_WIN) + (size_t)l * DIN * DM, MROWS, DIN, DM}; pg8::StaticOrder S; S.init(MROWS, DIN, gridDim.x, (int)blockIdx.x);
            pg8::EpiProj E{(bf16*)(ws + WS_PROJ), (const float*)(ws + WS_ROWSS) + l * MROWS, DIN};
            pg8::gemm_phase<pg8::EpiProj, pg8::StaticOrder, true, true>(lds, g, S, E);
        }
#endif
        GRID_BAR();
#ifndef NO_P2
        for (int rep2 = 0; rep2 < REP_P2; ++rep2)
        for (int T = blockIdx.x; T < NTILES; T += gridDim.x) {
            int tid = threadIdx.x; asm volatile("" : "+v"(tid)); const int lane = tid & 63, wave = __builtin_amdgcn_readfirstlane(tid >> 6);
            unsigned char* ws = KWS; const bf16* proj = (const bf16*)(ws + WS_PROJ); bf16* ybuf = (bf16*)(ws + WS_Y);
#ifndef NO_MC
            { bf16* hloc = (bf16*)(ws + WS_H); float* aggL = (float*)(ws + WS_AGG);
            mixer_c(lds, proj, (const bf16*)(ws + WS_WA) + l * 8 * 4096, (const bf16*)(ws + WS_WX) + l * 8 * 4096, KIN(9) + l * 4 * 512, KIN(10) + l * 512,
                    KIN(12) + l * 512, KIN(14) + l * 512, KIN(15) + l * 512, hloc, hloc + (size_t)MROWS * 512, aggL, aggL + NTILES * 512, T, wave, lane); }
#endif
#ifndef NO_MA
            mixer_a(lds, proj, (const bf16*)(ws + WS_SGUW) + l * 4 * 128 * 128, KIN(3) + l * 256, KIN(5) + l * 512, ybuf, T, tid, wave, lane);
#endif
#ifndef NO_MB
            mixer_b(lds, proj, (const bf16*)(ws + WS_POOLW) + l * 4 * 4096, KIN(7) + l * 256, KIN(8) + l * 256, ybuf, T, tid, wave, lane);
#endif
            __syncthreads();
        }
#endif
        GRID_BAR();
#ifndef NO_P3
        for (int rep3 = 0; rep3 < REP_P3; ++rep3)
        for (int T = blockIdx.x; T < NTILES; T += gridDim.x) {
            int tid = threadIdx.x; asm volatile("" : "+v"(tid)); unsigned char* ws = KWS; const bf16* hloc = (const bf16*)(ws + WS_H); const float* aggL = (const float*)(ws + WS_AGG);
            p3_tile(lds, (const bf16*)(ws + WS_PROJ), hloc, hloc + (size_t)MROWS * 512, aggL, aggL + NTILES * 512, (bf16*)(ws + WS_Y), T, tid, __builtin_amdgcn_readfirstlane(tid >> 6), tid & 63);
        }
#endif
        GRID_BAR();
#ifndef NO_P4
        {
            unsigned char* ws = KWS; float* out = KOUT;
            pg8::Gemm g{(const bf16*)(ws + WS_Y), (const bf16*)(ws + WS_WOUT) + (size_t)l * DM * DM, MROWS, DM, DM}; pg8::StaticOrder S; S.init(MROWS, DM, gridDim.x, (int)blockIdx.x);
            pg8::EpiOut E{l == 0 ? KIN(0) : (const float*)out, out, l == 0 ? (bf16*)(ws + WS_H) : (bf16*)nullptr, (float*)(ws + WS_ROWSS) + (l + 1) * MROWS};
            pg8::gemm_phase<pg8::EpiOut, pg8::StaticOrder, true, true>(lds, g, S, E);
#ifdef REP_P4
            if (l == 0) { pg8::EpiOut E2{KIN(0), out, (bf16*)(ws + WS_H), (float*)(ws + WS_END)}; pg8::gemm_phase<pg8::EpiOut, pg8::StaticOrder, true, true>(lds, g, S, E2); }
#endif
        }
#endif
        GRID_BAR();
    }
    {
        int tid = threadIdx.x; asm volatile("" : "+v"(tid)); const int lane = tid & 63, wave = __builtin_amdgcn_readfirstlane(tid >> 6);
        const int gw = blockIdx.x * NWAVES + wave, NGW = gridDim.x * NWAVES; const float* fg = KIN(18); float* out = KOUT; const float* rowss = (const float*)(KWS + WS_ROWSS) + 2 * MROWS;
        f32x4 gv[4];
#pragma unroll
        for (int j = 0; j < 4; ++j) gv[j] = ((const f32x4*)fg)[64 * j + lane];
        for (int m = gw; m < MROWS; m += NGW) { f32x4* xr = (f32x4*)(out + (size_t)m * DM) + lane; const float rstd = __builtin_amdgcn_rsqf(rowss[m] * (1.0f / 1024.0f) + EPS);
#pragma unroll
            for (int j = 0; j < 4; ++j) { const f32x4 v = xr[64 * j]; xr[64 * j] = v * rstd * gv[j]; } }
    }
}

extern "C" void kernel_launch(void* const* d_in, const int* in_sizes, int n_in, void* d_out, int out_size, void* d_ws, size_t ws_size, hipStream_t stream) {
    static int grid = 0;
    if (grid == 0) {
        int dev = 0, cus = 0, per_cu = 0;
        if (n_in != 19 || out_size != MROWS * DM || ws_size < WS_END) { fprintf(stderr, "kernel_launch: unexpected shapes (n_in %d out %d ws %zu)\n", n_in, out_size, ws_size); grid = -1; return; }
        hipGetDevice(&dev); hipDeviceGetAttribute(&cus, hipDeviceAttributeMultiprocessorCount, dev);
        if (hipFuncSetAttribute((const void*)hybrid_fwd, hipFuncAttributeMaxDynamicSharedMemorySize, LDS_BYTES) != hipSuccess) { fprintf(stderr, "kernel_launch: hipFuncSetAttribute failed\n"); }
        if (hipOccupancyMaxActiveBlocksPerMultiprocessor(&per_cu, (const void*)hybrid_fwd, NTHR, LDS_BYTES) != hipSuccess || per_cu < 1) per_cu = 1;
        (void)hipGetLastError();
        if (per_cu > 1) per_cu = 1;
        grid = cus * per_cu;
        if (grid < 1) grid = 256;
    }
    if (grid < 0) return;
    Params p{};
    for (int i = 0; i < 19; ++i) p.in[i] = (const float*)d_in[i];
    p.out = (float*)d_out; p.ws = (unsigned char*)d_ws;
    if (hipMemsetAsync((char*)d_ws + WS_CTL, 0, CTL_BYTES, stream) != hipSuccess) { fprintf(stderr, "kernel_launch: memset failed\n"); return; }
    void* args[] = {&p};
    hipError_t e = hipLaunchCooperativeKernel((const void*)hybrid_fwd, dim3(grid), dim3(NTHR), args, LDS_BYTES, stream);
    if (e != hipSuccess) fprintf(stderr, "kernel_launch: cooperative launch failed: %s (grid %d)\n", hipGetErrorString(e), grid);
}
```

```cpp
#include <hip/hip_runtime.h>
#include <hip/hip_cooperative_groups.h>
#include <cstdio>
#include <cstdint>
namespace cg = cooperative_groups;
namespace pg8 {
#define PG8_LAS __attribute__((address_space(3)))
typedef unsigned short bf16_t;
typedef short bf16x8 __attribute__((ext_vector_type(8)));
typedef float f32x4 __attribute__((ext_vector_type(4)));
typedef unsigned u32x4 __attribute__((ext_vector_type(4)));
constexpr int BM = 256, BK = 64, HALF = 128, HTB = HALF * BK * 2  , STAGE_BYTES = 8 * HTB, NXCD = 8, WGM = 8;

__host__ __device__ __forceinline__ int lds_byte(int r, int c) { const int st = (r >> 4) * 2 + (c >> 5), rr = r & 15, cc = c & 31, ob = rr * 64 + cc * 2; return st * 1024 + (ob ^ (((ob >> 9) & 1) << 5)); }
__host__ __device__ __forceinline__ void stage_rc(int b, int& R, int& C) { const int st = b / 1024, sb = b % 1024, swz = sb ^ (((sb >> 9) & 1) << 5); R = (st >> 1) * 16 + swz / 64; C = (st & 1) * 32 + (swz % 64) / 2; }
__host__ __device__ __forceinline__ int perm32(int rho) { const int n = rho >> 4, i = rho & 15; return 8 * (i >> 2) + 4 * n + (i & 3); }

struct Unit { int pm, pn; };
struct Gemm { const bf16_t* A; const bf16_t* Bt; int M, N, K; };

struct StaticOrder {
    int nM, nN, nwg, G, c;
    __host__ __device__ void init(int M, int N, int G_, int c_) { nM = M / BM; nN = N / BM; nwg = nM * nN; G = G_; c = c_; }
    __host__ __device__ bool next(int i, Unit& u) const {
        const long L = (long)i * G + c; if (L >= nwg) return false;
        int wgid = (int)L; { const int q = nwg / NXCD, r = nwg % NXCD, xcd = wgid % NXCD, off = wgid / NXCD; wgid = (xcd < r ? xcd * (q + 1) : r * (q + 1) + (xcd - r) * q) + off; }
        const int nig = WGM * nN, gid = wgid / nig, fm = gid * WGM, gsz = (nM - fm) < WGM ? (nM - fm) : WGM;
        u.pm = fm + ((wgid % nig) % gsz); u.pn = (wgid % nig) / gsz; return true;
    }
    __device__ __forceinline__ void a_ready(const Unit&) const {}
    __device__ __forceinline__ void done(const Unit&) const {}
};
struct PanelOrder {
    int c; const unsigned* ready; unsigned need;
    __device__ bool next(int i, Unit& u) const {
        const int late = c >> 7, cc = c & 127, slot = (cc & 7) * 16 + (cc >> 3);
        int base;
        if (!late) { if (i > 4) return false; base = (i == 0) ? 0 : (i == 1) ? 128 : (i == 2) ? 384 : (i == 3) ? 640 : 896; }
        else { if (i > 3) return false; base = 256 + 256 * i; }
        const int U = base + slot; u.pm = U / 9; u.pn = U - 9 * u.pm; return true;
    }
    __device__ __forceinline__ void a_ready(const Unit& u) const {
        if (threadIdx.x < 64) {
            unsigned sp = 0;
            while ((unsigned)__builtin_amdgcn_readfirstlane(__hip_atomic_load(ready + 64 * u.pm, __ATOMIC_RELAXED, __HIP_MEMORY_SCOPE_AGENT)) < need) { __builtin_amdgcn_s_sleep(2); if (++sp > (1u << 22)) break; }
            __builtin_amdgcn_fence(__ATOMIC_ACQUIRE, "agent");
            asm volatile("s_waitcnt vmcnt(0)" ::: "memory");
        }
        asm volatile("" ::: "memory"); __builtin_amdgcn_s_barrier(); asm volatile("" ::: "memory");
    }
    __device__ __forceinline__ void done(const Unit&) const {}
};

#if defined(__HIP_DEVICE_COMPILE__)
#define PG8_GAS __attribute__((address_space(1)))
#else
#define PG8_GAS
#endif
__device__ __forceinline__ unsigned cvt_pk_bf16(float lo, float hi) { unsigned r; asm volatile("v_cvt_pk_bf16_f32 %0, %1, %2" : "=v"(r) : "v"(lo), "v"(hi)); return r; }

struct EpiProj {
    static constexpr bool PERM = true, AFTER_DRAIN = false;
    PG8_GAS bf16_t* O; const PG8_GAS float* rowss; int ldc;
    __device__ __forceinline__ void operator()(const f32x4 (&acc)[2][2][4][2], const Unit& u, int wr, int wc, int fr, int fq) const {
        const int row0 = u.pm * BM + wr * 64 + fr, col0 = u.pn * BM + wc * 32 + 8 * fq;
#pragma unroll
        for (int ai = 0; ai < 2; ++ai)
#pragma unroll
            for (int m = 0; m < 4; ++m) {
                const int row = row0 + ai * HALF + m * 16;
                const float rs = __builtin_amdgcn_rsqf(rowss[row] * (1.0f / 1024.0f) + 1e-6f);
                PG8_GAS bf16_t* rowp = O + ((size_t)u.pn * 32768 + row) * 256 + (col0 - u.pn * BM);
#pragma unroll
                for (int bj = 0; bj < 2; ++bj) { const f32x4 v0 = acc[ai][bj][m][0] * rs, v1 = acc[ai][bj][m][1] * rs;
                    u32x4 w; w.x = cvt_pk_bf16(v0[0], v0[1]); w.y = cvt_pk_bf16(v0[2], v0[3]); w.z = cvt_pk_bf16(v1[0], v1[1]); w.w = cvt_pk_bf16(v1[2], v1[3]);
                    *(PG8_GAS u32x4*)(rowp + bj * HALF) = w; }
            }
    }
};
struct EpiOut {
    static constexpr bool PERM = true, AFTER_DRAIN = false;
    PG8_GAS bf16_t* hb; PG8_GAS float* rowss;
    __device__ __forceinline__ void operator()(const f32x4 (&acc)[2][2][4][2], const Unit& u, int wr, int wc, int fr, int fq) const {
        const int row0 = u.pm * BM + wr * 64 + fr, col0 = u.pn * BM + wc * 32 + 8 * fq;
#pragma unroll
        for (int ai = 0; ai < 2; ++ai) {
            u32x4 rw[4][2];
#pragma unroll
            for (int m = 0; m < 4; ++m)
#pragma unroll
                for (int bj = 0; bj < 2; ++bj) rw[m][bj] = *(const PG8_GAS u32x4*)(hb + (size_t)(row0 + ai * HALF + m * 16) * 1024 + col0 + bj * HALF);
#pragma unroll
            for (int m = 0; m < 4; ++m) {
                const int row = row0 + ai * HALF + m * 16;
                const size_t off = (size_t)row * 1024 + col0;
                float ss = 0.f;
#pragma unroll
                for (int bj = 0; bj < 2; ++bj) {
                    const u32x4 w0 = rw[m][bj];
                    const f32x4 r0 = {__uint_as_float(w0.x << 16), __uint_as_float(w0.x & 0xffff0000u), __uint_as_float(w0.y << 16), __uint_as_float(w0.y & 0xffff0000u)};
                    const f32x4 r1 = {__uint_as_float(w0.z << 16), __uint_as_float(w0.z & 0xffff0000u), __uint_as_float(w0.w << 16), __uint_as_float(w0.w & 0xffff0000u)};
                    const f32x4 v0 = acc[ai][bj][m][0] + r0, v1 = acc[ai][bj][m][1] + r1;
                    ss += (v0[0] * v0[0] + v0[1] * v0[1]) + (v0[2] * v0[2] + v0[3] * v0[3]) + (v1[0] * v1[0] + v1[1] * v1[1]) + (v1[2] * v1[2] + v1[3] * v1[3]);
                    u32x4 w; w.x = cvt_pk_bf16(v0[0], v0[1]); w.y = cvt_pk_bf16(v0[2], v0[3]); w.z = cvt_pk_bf16(v1[0], v1[1]); w.w = cvt_pk_bf16(v1[2], v1[3]);
                    *(PG8_GAS u32x4*)(hb + off + bj * HALF) = w;
                }
                ss += __shfl_xor(ss, 16); ss += __shfl_xor(ss, 32);
                if (fq == 0) __hip_atomic_fetch_add(rowss + row, ss, __ATOMIC_RELAXED, __HIP_MEMORY_SCOPE_AGENT);
            }
        }
    }
};
struct EpiOutFinal {
    static constexpr bool PERM = true, AFTER_DRAIN = false;
    const PG8_GAS bf16_t* resid; PG8_GAS float* out; PG8_GAS float* rowss; PG8_GAS unsigned* cnt; const PG8_GAS float* fg; const PG8_GAS unsigned* dbg;
    __device__ __forceinline__ void operator()(f32x4 (&acc)[2][2][4][2], const Unit& u, int wr, int wc, int fr, int fq) const {
        const int row0 = u.pm * BM + wr * 64 + fr, col0 = u.pn * BM + wc * 32 + 8 * fq;
#pragma unroll
        for (int am = 0; am < 4; ++am) { const int ai = am >> 1;
            f32x4 r[4][2][2];
#pragma unroll
            for (int m = 2 * (am & 1); m < 2 * (am & 1) + 2; ++m)
#pragma unroll
                for (int bj = 0; bj < 2; ++bj) { const size_t off = (size_t)(row0 + ai * HALF + m * 16) * 1024 + col0 + bj * HALF;
                    const u32x4 w = *(const PG8_GAS u32x4*)(resid + off);
                    r[m][bj][0] = (f32x4){__uint_as_float(w.x << 16), __uint_as_float(w.x & 0xffff0000u), __uint_as_float(w.y << 16), __uint_as_float(w.y & 0xffff0000u)};
                    r[m][bj][1] = (f32x4){__uint_as_float(w.z << 16), __uint_as_float(w.z & 0xffff0000u), __uint_as_float(w.w << 16), __uint_as_float(w.w & 0xffff0000u)}; }
#pragma unroll
            for (int m = 2 * (am & 1); m < 2 * (am & 1) + 2; ++m) {
                const int row = row0 + ai * HALF + m * 16;
                float ss = 0.f;
#pragma unroll
                for (int bj = 0; bj < 2; ++bj) {
                    const f32x4 v0 = acc[ai][bj][m][0] + r[m][bj][0], v1 = acc[ai][bj][m][1] + r[m][bj][1];
                    acc[ai][bj][m][0] = v0; acc[ai][bj][m][1] = v1;
                    ss += (v0[0] * v0[0] + v0[1] * v0[1]) + (v0[2] * v0[2] + v0[3] * v0[3]) + (v1[0] * v1[0] + v1[1] * v1[1]) + (v1[2] * v1[2] + v1[3] * v1[3]);
                }
                ss += __shfl_xor(ss, 16); ss += __shfl_xor(ss, 32);
                if (fq == 0) __hip_atomic_fetch_add(rowss + row, ss, __ATOMIC_RELAXED, __HIP_MEMORY_SCOPE_AGENT);
            }
        }
        asm volatile("s_waitcnt vmcnt(0)" ::: "memory");
        PG8_GAS unsigned* c = cnt + 64 * u.pm;
        if ((threadIdx.x & 63) == 0) __hip_atomic_fetch_add(c, 1u, __ATOMIC_RELAXED, __HIP_MEMORY_SCOPE_AGENT);
        { unsigned sp = 0; while ((unsigned)__builtin_amdgcn_readfirstlane(__hip_atomic_load(c, __ATOMIC_RELAXED, __HIP_MEMORY_SCOPE_AGENT)) < 32u) { __builtin_amdgcn_s_sleep(2); if (++sp > (1u << 22)) break; } }
        asm volatile("" ::: "memory");
        f32x4 g0[2], g1[2];
#ifdef TS_A
        const float dlt = (float)dbg[0] * 1e-7f;
#else
        const float dlt = 0.f;
#endif
#pragma unroll
        for (int bj = 0; bj < 2; ++bj) { g0[bj] = *(const PG8_GAS f32x4*)(fg + col0 + bj * HALF); g1[bj] = *(const PG8_GAS f32x4*)(fg + col0 + bj * HALF + 4); }
#pragma unroll
        for (int ai = 0; ai < 2; ++ai)
#pragma unroll
            for (int m = 0; m < 4; ++m) {
                const int row = row0 + ai * HALF + m * 16;
                const float rs = __builtin_amdgcn_rsqf(__hip_atomic_load(rowss + row, __ATOMIC_RELAXED, __HIP_MEMORY_SCOPE_AGENT) * (1.0f / 1024.0f) + 1e-6f);
                PG8_GAS float* o = out + (size_t)row * 1024 + col0;
#pragma unroll
                for (int bj = 0; bj < 2; ++bj) { *(PG8_GAS f32x4*)(o + bj * HALF) = acc[ai][bj][m][0] * rs * g0[bj] + dlt; *(PG8_GAS f32x4*)(o + bj * HALF + 4) = acc[ai][bj][m][1] * rs * g1[bj] + dlt; }
            }
    }
};

template <class Epi, class Sched, bool ALIGN_EPI = false, bool SP2 = false>
__device__ __forceinline__ void gemm_phase(PG8_LAS unsigned char* lds, const Gemm g, const Sched& S, const Epi& E) {
    int tid_ = threadIdx.x; asm volatile("" : "+v"(tid_));
    const int tid = tid_, wid = __builtin_amdgcn_readfirstlane(tid >> 6), lane = tid & 63, wr = wid >> 2, wc = wid & 3, fr = lane & 15, fq = lane >> 4;
    const int K = g.K, nt = K / BK;
    unsigned voffA[2], voffB[2];
#pragma unroll
    for (int i = 0; i < 2; ++i) { int R, C; stage_rc(tid * 16 + i * 8192, R, C); const int Rb = Epi::PERM ? ((R & ~31) + perm32(R & 31)) : R;
        voffA[i] = (unsigned)(R * K + C) * 2u; voffB[i] = (unsigned)(Rb * K + C) * 2u; }
    const size_t kstep = (size_t)(BK * 2);
    const size_t hstep = (size_t)HALF * K * 2;
    const size_t tstep = 2 * hstep;
    const unsigned ldsw = (unsigned)wid * 1024u;
    const int aoff = lds_byte(wr * 64 + fr, fq * 8), boff = lds_byte(wc * 32 + fr, fq * 8);
#define PG8_SA(b, h) (((b) * 2 + (h)) * HTB)
#define PG8_SB(b, h) ((4 + (b) * 2 + (h)) * HTB)
#define PG8_STAGE(bufoff, gbase, voff) do { _Pragma("unroll") for (int _i = 0; _i < 2; ++_i) \
        __builtin_amdgcn_global_load_lds((const unsigned*)((const char*)(gbase) + (voff)[_i]), (PG8_LAS unsigned*)(lds + (bufoff) + ldsw + _i * 8192), 16, 0, 0); } while (0)
#define PG8_LDA(dst, b, h) do { _Pragma("unroll") for (int m = 0; m < 4; ++m) _Pragma("unroll") for (int k = 0; k < 2; ++k) dst[m][k] = *(const PG8_LAS bf16x8*)(lds + PG8_SA(b, h) + aoff + m * 2048 + k * 1024); } while (0)
#define PG8_LDB(dst, b, h) do { _Pragma("unroll") for (int n = 0; n < 2; ++n) _Pragma("unroll") for (int k = 0; k < 2; ++k) dst[n][k] = *(const PG8_LAS bf16x8*)(lds + PG8_SB(b, h) + boff + n * 2048 + k * 1024); } while (0)
#define PG8_MMA(ai, bj, At, Bt) do { __builtin_amdgcn_s_setprio(1); _Pragma("unroll") for (int m = 0; m < 4; ++m) _Pragma("unroll") for (int n = 0; n < 2; ++n) _Pragma("unroll") for (int k = 0; k < 2; ++k) \
        acc[ai][bj][m][n] = __builtin_amdgcn_mfma_f32_16x16x32_bf16(Bt[n][k], At[m][k], acc[ai][bj][m][n], 0, 0, 0); __builtin_amdgcn_s_setprio(0); } while (0)
#define PG8_WAIT_V(n) asm volatile("s_waitcnt vmcnt(" #n ")" ::: "memory")
#define PG8_WAIT_L(n) asm volatile("s_waitcnt lgkmcnt(" #n ")" ::: "memory")
#define PG8_BAR __builtin_amdgcn_s_barrier()
#define PG8_SCHED __builtin_amdgcn_sched_barrier(0)
    Unit cur, nxt; int ui = 0;
    if (!S.next(0, cur)) return;
    f32x4 acc[2][2][4][2];
#pragma unroll
    for (int a = 0; a < 2; ++a)
#pragma unroll
        for (int b = 0; b < 2; ++b)
#pragma unroll
            for (int m = 0; m < 4; ++m)
#pragma unroll
                for (int n = 0; n < 2; ++n) acc[a][b][m][n] = (f32x4){0.f, 0.f, 0.f, 0.f};
    bf16x8 At[4][2], B0[2][2], B1[2][2];
    const char* cA = (const char*)g.A + (size_t)cur.pm * tstep; const char* cB = (const char*)g.Bt + (size_t)cur.pn * tstep;
    S.a_ready(cur);
    if constexpr (SP2) {
        PG8_STAGE(PG8_SB(0, 0), cB, voffB); PG8_STAGE(PG8_SB(0, 1), cB + hstep, voffB); PG8_STAGE(PG8_SA(0, 0), cA, voffA); PG8_STAGE(PG8_SA(0, 1), cA + hstep, voffA);
        if (wr == 1) PG8_BAR;
        PG8_WAIT_V(2); PG8_BAR;
        PG8_STAGE(PG8_SB(1, 0), cB + kstep, voffB); PG8_STAGE(PG8_SA(1, 0), cA + kstep, voffA); PG8_STAGE(PG8_SB(1, 1), cB + hstep + kstep, voffB);
        PG8_WAIT_V(6); PG8_BAR;
    } else {
        PG8_STAGE(PG8_SB(0, 0), cB, voffB); PG8_STAGE(PG8_SA(0, 0), cA, voffA); PG8_STAGE(PG8_SB(0, 1), cB + hstep, voffB); PG8_STAGE(PG8_SA(0, 1), cA + hstep, voffA);
        if (wr == 1) PG8_BAR;
        PG8_WAIT_V(4); PG8_BAR;
        PG8_STAGE(PG8_SB(1, 0), cB + kstep, voffB); PG8_STAGE(PG8_SA(1, 0), cA + kstep, voffA); PG8_STAGE(PG8_SB(1, 1), cB + hstep + kstep, voffB);
        PG8_WAIT_V(6); PG8_BAR;
    }
    for (;;) {
        const bool has_next = S.next(ui + 1, nxt);
        const char* nA = has_next ? (const char*)g.A + (size_t)nxt.pm * tstep : cA; const char* nB = has_next ? (const char*)g.Bt + (size_t)nxt.pn * tstep : cB;
        for (int t = 0; t < nt; t += 2) {
            const bool last = (t == nt - 2);
            const char* a1 = cA + (size_t)(t + 1) * kstep;
            const char* a2 = last ? nA : cA + (size_t)(t + 2) * kstep; const char* b2 = last ? nB : cB + (size_t)(t + 2) * kstep;
            const char* a3 = a2 + kstep; const char* b3 = b2 + kstep;
            if (last && has_next) S.a_ready(nxt);
            if constexpr (SP2) {
            PG8_LDB(B0, 0, 0); PG8_LDB(B1, 0, 1); PG8_SCHED; PG8_LDA(At, 0, 0); PG8_STAGE(PG8_SA(1, 1), a1 + hstep, voffA);
            PG8_WAIT_V(8); PG8_WAIT_L(0); PG8_BAR; PG8_MMA(0, 0, At, B0); PG8_MMA(0, 1, At, B1); PG8_BAR; PG8_SCHED;
            PG8_LDA(At, 0, 1); PG8_STAGE(PG8_SB(0, 0), b2, voffB); PG8_STAGE(PG8_SB(0, 1), b2 + hstep, voffB); PG8_STAGE(PG8_SA(0, 0), a2, voffA);
            PG8_WAIT_V(8); PG8_WAIT_L(0); PG8_BAR; PG8_MMA(1, 0, At, B0); PG8_MMA(1, 1, At, B1); PG8_BAR; PG8_SCHED;
            PG8_LDB(B0, 1, 0); PG8_LDB(B1, 1, 1); PG8_SCHED; PG8_LDA(At, 1, 0); PG8_STAGE(PG8_SA(0, 1), a2 + hstep, voffA);
            PG8_WAIT_V(8); PG8_WAIT_L(0); PG8_BAR; PG8_MMA(0, 0, At, B0); PG8_MMA(0, 1, At, B1); PG8_BAR; PG8_SCHED;
            PG8_LDA(At, 1, 1); PG8_STAGE(PG8_SB(1, 0), b3, voffB); PG8_STAGE(PG8_SB(1, 1), b3 + hstep, voffB); PG8_STAGE(PG8_SA(1, 0), a3, voffA);
            PG8_WAIT_V(8); PG8_WAIT_L(0); PG8_BAR; PG8_MMA(1, 0, At, B0); PG8_MMA(1, 1, At, B1); PG8_BAR; PG8_SCHED;
            } else {
            PG8_LDB(B0, 0, 0); PG8_SCHED; PG8_LDA(At, 0, 0); PG8_STAGE(PG8_SA(1, 1), a1 + hstep, voffA);
            PG8_WAIT_L(8); PG8_BAR; PG8_WAIT_L(0); PG8_MMA(0, 0, At, B0); PG8_BAR; PG8_SCHED;
            PG8_LDB(B1, 0, 1); PG8_STAGE(PG8_SB(0, 0), b2, voffB);
            PG8_BAR; PG8_WAIT_L(0); PG8_MMA(0, 1, At, B1); PG8_BAR;
            PG8_LDA(At, 0, 1); PG8_STAGE(PG8_SA(0, 0), a2, voffA);
            PG8_BAR; PG8_WAIT_L(0); PG8_MMA(1, 0, At, B0); PG8_BAR; PG8_SCHED;
            PG8_STAGE(PG8_SB(0, 1), b2 + hstep, voffB);
            PG8_WAIT_V(6); PG8_BAR; PG8_MMA(1, 1, At, B1); PG8_BAR;
            PG8_LDB(B0, 1, 0); PG8_SCHED; PG8_LDA(At, 1, 0); PG8_STAGE(PG8_SA(0, 1), a2 + hstep, voffA);
            PG8_WAIT_L(8); PG8_BAR; PG8_WAIT_L(0); PG8_MMA(0, 0, At, B0); PG8_BAR; PG8_SCHED;
            PG8_LDB(B1, 1, 1); PG8_STAGE(PG8_SB(1, 0), b3, voffB);
            PG8_BAR; PG8_WAIT_L(0); PG8_MMA(0, 1, At, B1); PG8_BAR;
            PG8_LDA(At, 1, 1); PG8_STAGE(PG8_SA(1, 0), a3, voffA);
            PG8_BAR; PG8_WAIT_L(0); PG8_MMA(1, 0, At, B0); PG8_BAR; PG8_SCHED;
            PG8_STAGE(PG8_SB(1, 1), b3 + hstep, voffB);
            PG8_WAIT_V(6); PG8_BAR; PG8_MMA(1, 1, At, B1); PG8_BAR;
            }
        }
        if constexpr (ALIGN_EPI) { if (wr == 0) PG8_BAR; }
        if constexpr (!Epi::AFTER_DRAIN) { E(acc, cur, wr, wc, fr, fq); S.done(cur); }
        if (!has_next) break;
#pragma unroll
        for (int a = 0; a < 2; ++a)
#pragma unroll
            for (int b = 0; b < 2; ++b)
#pragma unroll
                for (int m = 0; m < 4; ++m)
#pragma unroll
                    for (int n = 0; n < 2; ++n) acc[a][b][m][n] = (f32x4){0.f, 0.f, 0.f, 0.f};
        cur = nxt; cA = nA; cB = nB; ++ui;
        if constexpr (ALIGN_EPI) { if (wr == 1) PG8_BAR; }
    }
    PG8_WAIT_V(0);
    if constexpr (!ALIGN_EPI) { if (wr == 0) PG8_BAR; }
    PG8_BAR;
    if constexpr (Epi::AFTER_DRAIN) { E.fused(acc, cur, wr, wc, fr, fq, lds, wid, lane); S.done(cur); }
#undef PG8_SA
#undef PG8_SB
#undef PG8_STAGE
#undef PG8_LDA
#undef PG8_LDB
#undef PG8_MMA
#undef PG8_WAIT_V
#undef PG8_WAIT_L
#undef PG8_BAR
#undef PG8_SCHED
}
}

constexpr int NWAVES = 8, NTHR = 512;
constexpr int MROWS = 32768, DM = 1024, DIN = 2304, SEQ = 4096, TILE = 128, NTILES = MROWS / TILE, TPS = SEQ / TILE;
constexpr size_t PTILE = (size_t)MROWS * 256;
constexpr int OFF_AU = 0, OFF_AV = 256, OFF_AZ = 512, OFF_BX = 768, OFF_BZ = 1024, OFF_CX = 1280, OFF_CZ = 1792;
constexpr float EPS = 1e-6f;
constexpr size_t MiB = 1u << 20;
constexpr size_t WS_WIN = 0;
constexpr size_t WS_WOUT = 9 * MiB;
constexpr size_t WS_SGUW = 13 * MiB;
constexpr size_t WS_POOLW = 13 * MiB + 256 * 1024;
constexpr size_t WS_WA = 13 * MiB + 512 * 1024;
constexpr size_t WS_WX = 13 * MiB + 768 * 1024;
constexpr size_t WS_ROWSS = 14 * MiB;
constexpr size_t WS_CTL = 14 * MiB + 512 * 1024, CTL_PANEL = 16384, CTL_FLAGS = 16384 + 32768, CTL_DBG = 16384 + 32768 + 32768, CTL_READY = 16384 + 32768 + 32768 + 256, CTL_BYTES = 16384 + 32768 + 32768 + 256 + 32768;
constexpr size_t WS_AGG = 15 * MiB;
constexpr size_t WS_H = 16 * MiB;
constexpr size_t WS_PROJ = 80 * MiB;
constexpr size_t WS_Y = 224 * MiB;
constexpr size_t WS_SCAN = 288 * MiB;
constexpr size_t WS_END = 352 * MiB;
constexpr int LDS_BYTES = 163840;

#define LAS __attribute__((address_space(3)))
#if defined(__HIP_DEVICE_COMPILE__)
#define GAS __attribute__((address_space(1)))
#else
#define GAS
#endif
typedef unsigned short bf16;
typedef unsigned v4u __attribute__((ext_vector_type(4)));
typedef unsigned v2u __attribute__((ext_vector_type(2)));
typedef float f32x4 __attribute__((ext_vector_type(4)));
typedef short bf16x8 __attribute__((ext_vector_type(8)));
typedef float f32x2 __attribute__((ext_vector_type(2)));

__device__ __forceinline__ unsigned pk2(float lo, float hi) { return pg8::cvt_pk_bf16(lo, hi); }
__device__ __forceinline__ float bflo(unsigned w) { return __uint_as_float(w << 16); }
__device__ __forceinline__ float bfhi(unsigned w) { return __uint_as_float(w & 0xffff0000u); }
__device__ __forceinline__ float bf2f(bf16 b) { return __uint_as_float(((unsigned)b) << 16); }
__device__ __forceinline__ bf16 f2bf(float f) { return (bf16)(pk2(f, 0.f) & 0xffffu); }
__device__ __forceinline__ float fexp(float x) { return __builtin_amdgcn_exp2f(x * 1.4426950408889634f); }
__device__ __forceinline__ float sigm(float x) { return __builtin_amdgcn_rcpf(1.0f + fexp(-x)); }
__device__ __forceinline__ float silu(float x) { return x * sigm(x); }
__device__ __forceinline__ float wave_sum(float v) {
#pragma unroll
    for (int o = 1; o < 64; o <<= 1) v += __shfl_xor(v, o);
    return v;
}
__device__ __forceinline__ void unpack8(const v4u w, float (&x)[8]) {
    x[0] = bflo(w.x); x[1] = bfhi(w.x); x[2] = bflo(w.y); x[3] = bfhi(w.y); x[4] = bflo(w.z); x[5] = bfhi(w.z); x[6] = bflo(w.w); x[7] = bfhi(w.w);
}
__device__ __forceinline__ v4u pack8(const float (&x)[8]) { v4u w; w.x = pk2(x[0], x[1]); w.y = pk2(x[2], x[3]); w.z = pk2(x[4], x[5]); w.w = pk2(x[6], x[7]); return w; }
#define MFMA16(a, b, c) __builtin_amdgcn_mfma_f32_16x16x32_bf16((a), (b), (c), 0, 0, 0)

struct Params {
    const float* in[19];
    float* out; unsigned char* ws;
};

__device__ __forceinline__ void p0_transpose_item(const GAS float* W, const GAS float* gk, int K, int N, GAS bf16* WT, LAS float* scr, int item, int lane) {
    const int nblk = N / 32, kb = item / nblk, nb = item % nblk, k0 = 64 * kb, n0 = 32 * nb;
    float wv[32];
#pragma unroll
    for (int i = 0; i < 32; ++i) { const int kk = 2 * i + (lane >> 5); wv[i] = W[(size_t)(k0 + kk) * N + n0 + (lane & 31)]; }
    const float g0 = gk[k0 + (lane & 31) + 0], g1 = gk[k0 + (lane & 31) + 32];
#pragma unroll
    for (int i = 0; i < 32; ++i) { const int kk = 2 * i + (lane >> 5); const float gsel = __shfl((2 * i < 32) ? g0 : g1, (lane & 32) + ((2 * i + (lane >> 5)) & 31)); scr[kk * 33 + (lane & 31)] = wv[i] * gsel; }
    asm volatile("s_waitcnt lgkmcnt(0)" ::: "memory");
    const int c = lane & 7;
#pragma unroll
    for (int j = 0; j < 4; ++j) { const int n = (lane >> 3) + 8 * j; const LAS float* s = scr + (8 * c) * 33 + n;
        v4u o; o.x = pk2(s[0 * 33], s[1 * 33]); o.y = pk2(s[2 * 33], s[3 * 33]); o.z = pk2(s[4 * 33], s[5 * 33]); o.w = pk2(s[6 * 33], s[7 * 33]);
        *(GAS v4u*)(WT + (size_t)(n0 + n) * K + k0 + 8 * c) = o; }
    asm volatile("s_waitcnt lgkmcnt(0)" ::: "memory");
}
__device__ __forceinline__ void p0_prologue(const Params& p, LAS unsigned char* lds, int tid, int lane, int wave) {
    unsigned char* ws = p.ws;
    LAS float* scr = (LAS float*)(lds + wave * 16384);
    const int G = gridDim.x, gw = blockIdx.x * NWAVES + wave, NGW = G * NWAVES;
    constexpr int I_IN = (DM / 64) * (DIN / 32), I_OUT = (DM / 64) * (DM / 32);
    for (int it = gw; it < I_IN; it += NGW)
        p0_transpose_item((const GAS float*)p.in[2], (const GAS float*)p.in[1], DM, DIN, (GAS bf16*)(ws + WS_WIN), scr, it, lane);
    const int gt = blockIdx.x * NTHR + tid, NGT = G * NTHR;
    for (int i = gt; i < 2 * 4 * 128 * 128; i += NGT) { const int jj = i & 127, ii = (i >> 7) & 127; const float m = ((jj >> 6) <= (ii >> 6)) ? 1.f : 0.f; ((GAS bf16*)(ws + WS_SGUW))[i] = f2bf(p.in[4][i] * m); }
    for (int i = gt; i < 2 * 4 * 64 * 64; i += NGT) { const int ii = i & 63, o = (i >> 6) & 63, lg = i >> 12; ((GAS bf16*)(ws + WS_POOLW))[i] = f2bf(p.in[6][(lg * 64 + ii) * 64 + o]); }
    for (int i = gt; i < 2 * 8 * 64 * 64; i += NGT) { const int ii = i & 63, o = (i >> 6) & 63, lh = i >> 12;
        ((GAS bf16*)(ws + WS_WA))[i] = f2bf(p.in[11][(lh * 64 + ii) * 64 + o]); ((GAS bf16*)(ws + WS_WX))[i] = f2bf(p.in[13][(lh * 64 + ii) * 64 + o]); }
    GAS float* rowss = (GAS float*)(ws + WS_ROWSS);
    for (int i = gt; i < 2 * MROWS; i += NGT) rowss[MROWS + i] = 0.f;
    {   const GAS float* x = (const GAS float*)p.in[0]; GAS bf16* hb = (GAS bf16*)(ws + WS_H);
        for (int m = gw; m < 4096; m += NGW) { const f32x4* xr = (const GAS f32x4*)(x + (size_t)m * DM) + lane; f32x4 v[4]; float s = 0.f;
#pragma unroll
            for (int j = 0; j < 4; ++j) v[j] = __builtin_nontemporal_load(xr + 64 * j);
            GAS unsigned long long* o8 = (GAS unsigned long long*)(hb + (size_t)m * DM) + lane;
#pragma unroll
            for (int j = 0; j < 4; ++j) { const f32x4 w = v[j]; s += (w.x * w.x + w.y * w.y) + (w.z * w.z + w.w * w.w); o8[64 * j] = (unsigned long long)pk2(w.x, w.y) | ((unsigned long long)pk2(w.z, w.w) << 32); }
            s = wave_sum(s);
            if (lane == 0) rowss[m] = s; }
        if (blockIdx.x == 0 && tid < 16) __hip_atomic_store((GAS unsigned*)(ws + WS_CTL + CTL_READY) + 64 * tid, 8u, __ATOMIC_RELAXED, __HIP_MEMORY_SCOPE_AGENT);
    }
}
__device__ __forceinline__ void p0b_convert(const GAS float* x, GAS unsigned char* ws, int lb, int lane, int wave) {
    GAS bf16* hb = (GAS bf16*)(ws + WS_H); GAS float* rowss = (GAS float*)(ws + WS_ROWSS); GAS unsigned* ready = (GAS unsigned*)(ws + WS_CTL + CTL_READY);
    const int q = lb >> 3, mem = lb & 7;
#pragma unroll 1
    for (int k = 1; k < 8; ++k) {
        const int pnl = 16 * k + q; const size_t r0 = (size_t)pnl * 256 + 32 * mem + 4 * wave;
        f32x4 v[4][4];
#pragma unroll
        for (int qq = 0; qq < 4; ++qq) { const f32x4* xr = (const GAS f32x4*)(x + (r0 + qq) * DM) + lane;
#pragma unroll
            for (int j = 0; j < 4; ++j) v[qq][j] = __builtin_nontemporal_load(xr + 64 * j); }
#pragma unroll
        for (int qq = 0; qq < 4; ++qq) { float s = 0.f; GAS unsigned long long* o8 = (GAS unsigned long long*)(hb + (r0 + qq) * DM) + lane;
#pragma unroll
            for (int j = 0; j < 4; ++j) { const f32x4 w = v[qq][j]; s += (w.x * w.x + w.y * w.y) + (w.z * w.z + w.w * w.w);
                __hip_atomic_store(o8 + 64 * j, (unsigned long long)pk2(w.x, w.y) | ((unsigned long long)pk2(w.z, w.w) << 32), __ATOMIC_RELAXED, __HIP_MEMORY_SCOPE_AGENT); }
            s = wave_sum(s);
            if (lane == 0) __hip_atomic_store(rowss + r0 + qq, s, __ATOMIC_RELAXED, __HIP_MEMORY_SCOPE_AGENT); }
        asm volatile("s_waitcnt vmcnt(0)" ::: "memory");
        __syncthreads();
        if (threadIdx.x == 0) __hip_atomic_fetch_add(ready + 64 * pnl, 1u, __ATOMIC_RELAXED, __HIP_MEMORY_SCOPE_AGENT);
    }
}

__device__ __forceinline__ void p0_deferred(const GAS float* w_in1, const GAS float* g1, const GAS float* w_out, const GAS float* bg, GAS unsigned char* ws, LAS unsigned char* lds, int first, int nb, int lane, int wave) {
    LAS float* scr = (LAS float*)(lds + wave * 16384);
    const int gw = ((int)blockIdx.x - first) * NWAVES + wave, NGW = nb * NWAVES;
    constexpr int I_IN = (DM / 64) * (DIN / 32), I_OUT = (DM / 64) * (DM / 32);
    for (int it = gw; it < I_IN + 2 * I_OUT; it += NGW) {
        int r = it;
        if (r < I_IN) { p0_transpose_item(w_in1, g1, DM, DIN, (GAS bf16*)(ws + WS_WIN) + (size_t)DIN * DM, scr, r, lane); continue; }
        r -= I_IN; { const int l = r / I_OUT; r -= l * I_OUT;
            p0_transpose_item(w_out + (size_t)l * DM * DM, bg + l * DM, DM, DM, (GAS bf16*)(ws + WS_WOUT) + (size_t)l * DM * DM, scr, r, lane); }
    }
}

static_assert(36864 + 16 * (8 - 3) * 1536 <= 163840 - 64, "parked scan rows fit in LDS");
constexpr int PARK_M0 = 3, PARK_ROWS = 16 * (8 - PARK_M0), L_PARKH = 36864, L_PARKP = L_PARKH + PARK_ROWS * 1024, L_YT = 73728, L_RSTDV = L_YT + 67584, L_HIN = 0, L_MISC = LDS_BYTES - 64;

__device__ __forceinline__ void mixer_c(LAS unsigned char* lds, const GAS bf16* proj, const GAS bf16* waT, const GAS bf16* wxT, const GAS float* conv_w, const GAS float* conv_b,
                                        const GAS float* lba, const GAS float* lbx, const GAS float* lam, GAS bf16* hloc, GAS unsigned char* Pbuf, GAS float* aggL, GAS float* aggH, int T, int wid, int lane) {
    const int h = wid, g = lane >> 4, o = lane & 15, tt = T % TPS;
    const size_t R0 = (size_t)T * TILE;
    LAS unsigned char* cimg = lds + wid * 4608;
    bf16x8 WA[4][2], WX[4][2];
#pragma unroll
    for (int n = 0; n < 4; ++n)
#pragma unroll
        for (int kk = 0; kk < 2; ++kk) { const int idx = (h * 64 + 16 * n + o) * 64 + 32 * kk + 8 * g; WA[n][kk] = *(const GAS bf16x8*)(waT + idx); WX[n][kk] = *(const GAS bf16x8*)(wxT + idx); }
    float nba[4], nbx[4], psp[4], pspl[4], hc[4], Pc[4];
#pragma unroll
    for (int n = 0; n < 4; ++n) { const int c = 64 * h + 16 * n + o; nba[n] = -1.4426950408889634f * lba[c]; nbx[n] = -1.4426950408889634f * lbx[c];
        const float xm = -lam[c]; psp[n] = -8.0f * (fmaxf(xm, 0.f) + log1pf(expf(-fabsf(xm)))); pspl[n] = psp[n] * 1.4426950408889634f; hc[n] = 0.f; Pc[n] = 1.0f; }
#pragma unroll 1
    for (int half = 0; half < 4; ++half) {
        {
            const int oc = lane & 15, seg = lane >> 4, cc = 64 * h + 4 * oc;
            f32x4 cw0 = *(const GAS f32x4*)(conv_w + cc), cw1 = *(const GAS f32x4*)(conv_w + 512 + cc), cw2 = *(const GAS f32x4*)(conv_w + 1024 + cc), cw3 = *(const GAS f32x4*)(conv_w + 1536 + cc), cb = *(const GAS f32x4*)(conv_b + cc);
            const int t0 = 32 * half + 8 * seg;
            const GAS bf16* base = proj + (size_t)((OFF_CX + cc) >> 8) * PTILE + (R0 + t0) * 256 + ((OFF_CX + cc) & 255);
            const bool pv = (t0 > 0) || (tt > 0);
            v2u rw[11];
#pragma unroll
            for (int r = 0; r < 11; ++r) { rw[r] = (v2u){0u, 0u}; if (r >= 3 || pv) rw[r] = *(const GAS v2u*)(base + (r - 3) * 256); }
            f32x4 x0 = {bflo(rw[0].x), bfhi(rw[0].x), bflo(rw[0].y), bfhi(rw[0].y)}, x1 = {bflo(rw[1].x), bfhi(rw[1].x), bflo(rw[1].y), bfhi(rw[1].y)}, x2 = {bflo(rw[2].x), bfhi(rw[2].x), bflo(rw[2].y), bfhi(rw[2].y)};
#pragma unroll
            for (int r = 0; r < 8; ++r) {
                const v2u w = rw[r + 3]; const f32x4 cur = {bflo(w.x), bfhi(w.x), bflo(w.y), bfhi(w.y)};
                const f32x4 cv = cb + cw0 * x0 + cw1 * x1 + cw2 * x2 + cw3 * cur; x0 = x1; x1 = x2; x2 = cur;
                v2u ov; ov.x = pk2(cv.x, cv.y); ov.y = pk2(cv.z, cv.w);
                *(LAS v2u*)(cimg + (8 * seg + r) * 144 + oc * 8) = ov;
            }
        }
        asm volatile("s_waitcnt lgkmcnt(0)" ::: "memory");
#pragma unroll 1
        for (int mm = 0; mm < 2; ++mm) {
            const int m = 2 * half + mm;
            bf16x8 XA[2];
#pragma unroll
            for (int kk = 0; kk < 2; ++kk) XA[kk] = *(const LAS bf16x8*)(cimg + (16 * mm + o) * 144 + (32 * kk + 8 * g) * 2);
#pragma unroll
            for (int n = 0; n < 4; ++n) {
                f32x4 Da = {0.f, 0.f, 0.f, 0.f}, Dx = {0.f, 0.f, 0.f, 0.f};
                Da = MFMA16(XA[0], WA[n][0], Da); Da = MFMA16(XA[1], WA[n][1], Da);
                Dx = MFMA16(XA[0], WX[n][0], Dx); Dx = MFMA16(XA[1], WX[n][1], Dx);
                float aa[4], bb[4];
#pragma unroll
                for (int hp = 0; hp < 2; ++hp) {
                    const f32x2 da = {Da[2 * hp], Da[2 * hp + 1]}, dx = {Dx[2 * hp], Dx[2 * hp + 1]};
                    f32x2 ta = da * (-1.4426950408889634f) + nba[n], tx = dx * (-1.4426950408889634f) + nbx[n];
                    ta = __builtin_elementwise_min(__builtin_elementwise_max(ta, (f32x2){-40.f, -40.f}), (f32x2){40.f, 40.f}); tx = __builtin_elementwise_min(__builtin_elementwise_max(tx, (f32x2){-40.f, -40.f}), (f32x2){40.f, 40.f});
                    f32x2 ea, ex; ea.x = __builtin_amdgcn_exp2f(ta.x); ea.y = __builtin_amdgcn_exp2f(ta.y); ex.x = __builtin_amdgcn_exp2f(tx.x); ex.y = __builtin_amdgcn_exp2f(tx.y);
                    const f32x2 qa = ea + 1.0f, qx = ex + 1.0f, qq = qa * qx;
                    f32x2 rc; rc.x = __builtin_amdgcn_rcpf(qq.x); rc.y = __builtin_amdgcn_rcpf(qq.y);
                    const f32x2 r = qx * rc, ig = qa * rc;
                    const f32x2 la = r * psp[n], al = r * pspl[n], x2v = la + la;
                    f32x2 av; av.x = __builtin_amdgcn_exp2f(al.x); av.y = __builtin_amdgcn_exp2f(al.y);
                    f32x2 ser = x2v * 0.0083333338f + 0.041666668f; ser = ser * x2v + 0.16666667f; ser = ser * x2v + 0.5f; ser = ser * x2v + 1.0f; ser = ser * (-x2v);
                    const f32x2 fm = 1.0f - av * av;
                    f32x2 em; em.x = (x2v.x > -0.25f) ? ser.x : fm.x; em.y = (x2v.y > -0.25f) ? ser.y : fm.y;
                    f32x2 sq; sq.x = __builtin_amdgcn_sqrtf(em.x); sq.y = __builtin_amdgcn_sqrtf(em.y);
                    f32x2 cv; cv.x = bf2f(*(const LAS bf16*)(cimg + (16 * mm + 4 * g + 2 * hp) * 144 + (16 * n + o) * 2)); cv.y = bf2f(*(const LAS bf16*)(cimg + (16 * mm + 4 * g + 2 * hp + 1) * 144 + (16 * n + o) * 2));
                    const f32x2 bv = sq * ig * cv;
                    aa[2 * hp] = av.x; aa[2 * hp + 1] = av.y; bb[2 * hp] = bv.x; bb[2 * hp + 1] = bv.y;
                }
                float Hr[4], Ar[4], Hrun = 0.f, Arun = 1.0f;
#pragma unroll
                for (int reg = 0; reg < 4; ++reg) { Hrun = aa[reg] * Hrun + bb[reg]; Arun *= aa[reg]; Hr[reg] = Hrun; Ar[reg] = Arun; }
                float Ht = Hrun, At = Arun;
                { const float Hp = __shfl_up(Ht, 16), Ap = __shfl_up(At, 16); if (g >= 1) { Ht = At * Hp + Ht; At = Ap * At; } }
                { const float Hp = __shfl_up(Ht, 32), Ap = __shfl_up(At, 32); if (g >= 2) { Ht = At * Hp + Ht; At = Ap * At; } }
                float He = __shfl_up(Ht, 16), Ae = __shfl_up(At, 16); if (g == 0) { He = 0.f; Ae = 1.0f; }
                const float Hpre = Ae * hc[n] + He, Ppre = Pc[n] * Ae;
                float hv = 0.f, pv = 1.f;
                const size_t so = (R0 + 16 * m + 4 * g) * 512 + 64 * h + 16 * n + o;
#pragma unroll
                for (int reg = 0; reg < 4; ++reg) { hv = Hr[reg] + Ar[reg] * Hpre; pv = Ar[reg] * Ppre;
                    const bf16 hq = f2bf(hv); const unsigned char pq = (unsigned char)(pv * 255.0f + 0.5f);
                    if (m < PARK_M0) { hloc[so + reg * 512] = hq; Pbuf[so + reg * 512] = pq; }
                    else { const int pr = 16 * (m - PARK_M0) + 4 * g + reg, pc = 64 * h + 16 * n + o; *(LAS bf16*)(lds + L_PARKH + pr * 1024 + pc * 2) = hq; *(LAS unsigned char*)(lds + L_PARKP + pr * 512 + pc) = pq; } }
                hc[n] = __shfl(hv, 48 + o); Pc[n] = __shfl(pv, 48 + o);
            }
        }
    }
    if (g == 0) {
#pragma unroll
        for (int n = 0; n < 4; ++n) { const int c = 64 * h + 16 * n + o;
            __hip_atomic_store(aggL + (size_t)T * 512 + c, Pc[n], __ATOMIC_RELAXED, __HIP_MEMORY_SCOPE_AGENT); __hip_atomic_store(aggH + (size_t)T * 512 + c, hc[n], __ATOMIC_RELAXED, __HIP_MEMORY_SCOPE_AGENT); } }
    asm volatile("s_waitcnt vmcnt(0)" ::: "memory");
}

__device__ __forceinline__ void finish_rows(LAS unsigned char* ytile, const GAS bf16* mulp, const GAS bf16* zp, GAS bf16* outp, int tid) {
    const int c8 = 8 * (tid & 31), tb = tid >> 5;
#pragma unroll 4
    for (int i = 0; i < 8; ++i) { const int t = tb + 16 * i;
        float y[8], z[8]; unpack8(*(const LAS v4u*)(ytile + t * 528 + c8 * 2), y); unpack8(*(const GAS v4u*)(zp + (size_t)t * 256 + c8), z);
        if (mulp) { float u[8]; unpack8(*(const GAS v4u*)(mulp + (size_t)t * 256 + c8), u);
#pragma unroll
            for (int e = 0; e < 8; ++e) y[e] *= u[e]; }
        float ss = 0.f;
#pragma unroll
        for (int e = 0; e < 8; ++e) ss += y[e] * y[e];
        ss += __shfl_xor(ss, 1); ss += __shfl_xor(ss, 2); ss += __shfl_xor(ss, 4); ss += __shfl_xor(ss, 8); ss += __shfl_xor(ss, 16);
        const float rstd = __builtin_amdgcn_rsqf(ss * (1.0f / 256.0f) + EPS);
#pragma unroll
        for (int e = 0; e < 8; ++e) y[e] = y[e] * rstd * silu(z[e]);
        *(GAS v4u*)(outp + (size_t)t * DM + c8) = pack8(y); }
}

__device__ __forceinline__ void mixer_a(LAS unsigned char* lds, const GAS bf16* proj, const GAS bf16* sguW, const GAS float* sgu_g, const GAS float* sgu_b, GAS bf16* ybuf, int T, int tid, int wid, int lane) {
    const int g = lane >> 4, o = lane & 15;
    const size_t R0 = (size_t)T * TILE;
    LAS float* rstdv = (LAS float*)(lds + L_RSTDV); LAS unsigned char* ytile = lds + L_YT;
    { const int jo = tid & 15, co = tid >> 4;
        LAS float* part = (LAS float*)(lds + L_RSTDV + 512);
        float sg[8]; { const f32x4 a = *(const GAS f32x4*)(sgu_g + 8 * co), b = *(const GAS f32x4*)(sgu_g + 8 * co + 4); sg[0] = a.x; sg[1] = a.y; sg[2] = a.z; sg[3] = a.w; sg[4] = b.x; sg[5] = b.y; sg[6] = b.z; sg[7] = b.w; }
        v4u rows[8]; float rs[8];
#pragma unroll
        for (int r = 0; r < 8; ++r) rows[r] = *(const GAS v4u*)(proj + (size_t)(OFF_AV >> 8) * PTILE + (R0 + 8 * jo + r) * 256 + 8 * co);
#pragma unroll
        for (int r = 0; r < 8; ++r) { float x[8]; unpack8(rows[r], x); float s = 0.f;
#pragma unroll
            for (int e = 0; e < 8; ++e) s += x[e] * x[e];
            s += __shfl_xor(s, 16); s += __shfl_xor(s, 32);
            if (lane < 16) part[wid * 128 + 8 * jo + r] = s; }
        __syncthreads();
        if (tid < 128) { float s = 0.f;
#pragma unroll
            for (int w = 0; w < 8; ++w) s += part[w * 128 + tid];
            rstdv[tid] = __builtin_amdgcn_rsqf(s * (1.0f / 256.0f) + EPS); }
        __syncthreads();
#pragma unroll
        for (int r = 0; r < 8; ++r) rs[r] = rstdv[8 * jo + r];
#pragma unroll
        for (int e = 0; e < 8; ++e) { float v[8];
#pragma unroll
            for (int r = 0; r < 8; ++r) { const unsigned w = rows[r][e >> 1]; v[r] = ((e & 1) ? bfhi(w) : bflo(w)) * rs[r] * sg[e]; }
            *(LAS v4u*)(lds + (8 * co + e) * 272 + 16 * jo) = pack8(v); }
    }
    __syncthreads();
    const int h = wid & 3, hf = wid >> 2;
    bf16x8 XW[4][4];
#pragma unroll
    for (int m = 0; m < 4; ++m)
#pragma unroll
        for (int kk = 0; kk < 4; ++kk) { XW[m][kk] = (bf16x8){0, 0, 0, 0, 0, 0, 0, 0}; if (kk < 2 || hf) XW[m][kk] = *(const GAS bf16x8*)(sguW + ((h * 128 + 64 * hf + 16 * m + o) * 128 + 8 * g) + 32 * kk); }
#pragma unroll
    for (int m = 0; m < 4; ++m) {
        f32x4 D[4];
#pragma unroll
        for (int n = 0; n < 4; ++n) D[n] = (f32x4){0.f, 0.f, 0.f, 0.f};
#pragma unroll
        for (int kk = 0; kk < 4; ++kk) if (kk < 2 || hf) {
#pragma unroll
            for (int n = 0; n < 4; ++n) { const bf16x8 Y = *(const LAS bf16x8*)(lds + (64 * h + 16 * n + o) * 272 + (32 * kk + 8 * g) * 2); D[n] = MFMA16(XW[m][kk], Y, D[n]); }
        }
        const int tb = 64 * hf + 16 * m + 4 * g;
        const f32x4 bias = *(const GAS f32x4*)(sgu_b + h * 128 + tb);
#pragma unroll
        for (int reg = 0; reg < 4; ++reg)
#pragma unroll
            for (int n = 0; n < 4; ++n) *(LAS bf16*)(ytile + (tb + reg) * 528 + (64 * h + 16 * n + o) * 2) = f2bf(D[n][reg] + bias[reg]);
    }
    __syncthreads();
    finish_rows(ytile, proj + (size_t)(OFF_AU >> 8) * PTILE + R0 * 256, proj + (size_t)(OFF_AZ >> 8) * PTILE + R0 * 256, ybuf + R0 * DM, tid);
}

__device__ __forceinline__ void mixer_b(LAS unsigned char* lds, const GAS bf16* proj, const GAS bf16* poolWT, const GAS float* pool_b, const GAS float* pool_s, GAS bf16* ybuf, int T, int tid, int wid, int lane) {
    const int g = lane >> 4, o = lane & 15, tt = T % TPS;
    const size_t R0 = (size_t)T * TILE;
    LAS unsigned char* ytile = lds + L_YT;
    {
        const int oc = tid & 31, seg = tid >> 5, grp = oc >> 3, win = 2 << grp, t0 = 8 * seg;
        const GAS bf16* base = proj + (size_t)(OFF_BX >> 8) * PTILE + R0 * 256 + 8 * oc;
        v4u R[23];
#pragma unroll
        for (int i = 0; i < 23; ++i) { const int t = t0 - 15 + i; R[i] = (v4u){0u, 0u, 0u, 0u}; if (i >= 16 - win && (t >= 0 || tt > 0)) R[i] = *(const GAS v4u*)(base + (long)t * 256); }
        float S[8];
#pragma unroll
        for (int e = 0; e < 8; ++e) S[e] = 0.f;
#pragma unroll
        for (int i = 0; i < 15; ++i) { float x[8]; unpack8(R[i], x);
#pragma unroll
            for (int e = 0; e < 8; ++e) S[e] += x[e]; }
        const int pos0 = tt * TILE + t0;
#pragma unroll
        for (int r = 0; r < 8; ++r) { float cur[8], pv[8], od[8]; unpack8(R[15 + r], cur);
            const int cnt = min(pos0 + r + 1, win); const float inv = 1.0f / (float)cnt;
#pragma unroll
            for (int e = 0; e < 8; ++e) { S[e] += cur[e]; pv[e] = S[e] * inv - cur[e]; }
            *(LAS v4u*)(lds + (t0 + r) * 528 + oc * 16) = pack8(pv);
            v4u ow = R[r];
            if (grp == 0) ow = R[14 + r]; else if (grp == 1) ow = R[12 + r]; else if (grp == 2) ow = R[8 + r];
            unpack8(ow, od);
#pragma unroll
            for (int e = 0; e < 8; ++e) S[e] -= od[e];
        }
    }
    __syncthreads();
    const int gg = wid & 3, hf = wid >> 2;
    bf16x8 Y[4][2]; float pb[4], ps[4];
#pragma unroll
    for (int n = 0; n < 4; ++n) { const int c = 64 * gg + 16 * n + o; pb[n] = pool_b[c]; ps[n] = pool_s[c];
#pragma unroll
        for (int kk = 0; kk < 2; ++kk) Y[n][kk] = *(const GAS bf16x8*)(poolWT + ((gg * 64 + 16 * n + o) * 64 + 32 * kk + 8 * g)); }
#pragma unroll 1
    for (int m = 0; m < 4; ++m) {
        f32x4 D[4];
#pragma unroll
        for (int n = 0; n < 4; ++n) D[n] = (f32x4){0.f, 0.f, 0.f, 0.f};
#pragma unroll
        for (int kk = 0; kk < 2; ++kk) { const bf16x8 X = *(const LAS bf16x8*)(lds + (64 * hf + 16 * m + o) * 528 + (64 * gg + 32 * kk + 8 * g) * 2);
#pragma unroll
            for (int n = 0; n < 4; ++n) D[n] = MFMA16(X, Y[n][kk], D[n]); }
        const int tb = 64 * hf + 16 * m + 4 * g;
#pragma unroll
        for (int reg = 0; reg < 4; ++reg)
#pragma unroll
            for (int n = 0; n < 4; ++n) *(LAS bf16*)(ytile + (tb + reg) * 528 + (64 * gg + 16 * n + o) * 2) = f2bf((D[n][reg] + pb[n]) * ps[n]);
    }
    __syncthreads();
    finish_rows(ytile, (const GAS bf16*)nullptr, proj + (size_t)(OFF_BZ >> 8) * PTILE + R0 * 256, ybuf + R0 * DM + 256, tid);
}

__device__ __forceinline__ void p3_tile(LAS unsigned char* lds, const GAS bf16* proj, const GAS bf16* hloc, const GAS unsigned char* Pbuf, const GAS float* aggL, const GAS float* aggH, const GAS unsigned* flags, GAS bf16* ybuf, int T, int tid, int wid, int lane) {
    const int tt = T % TPS; const size_t R0 = (size_t)T * TILE;
    LAS float* hin = (LAS float*)(lds + L_HIN);
    const int Tb = T - tt;
    if (tid < tt) { const GAS unsigned* fw = flags + 16 * (Tb + tid); unsigned sp = 0;
        while (__hip_atomic_load(fw, __ATOMIC_RELAXED, __HIP_MEMORY_SCOPE_AGENT) == 0u) { __builtin_amdgcn_s_sleep(2); if (++sp > (1u << 22)) break; } }
    __syncthreads();
    { float Lv[31], Hv[31], hcar = 0.f;
#pragma unroll
        for (int j = 0; j < 31; ++j) { Lv[j] = 0.f; Hv[j] = 0.f; if (j < tt) { Lv[j] = __hip_atomic_load(aggL + (size_t)(Tb + j) * 512 + tid, __ATOMIC_RELAXED, __HIP_MEMORY_SCOPE_AGENT); Hv[j] = __hip_atomic_load(aggH + (size_t)(Tb + j) * 512 + tid, __ATOMIC_RELAXED, __HIP_MEMORY_SCOPE_AGENT); } }
#pragma unroll
        for (int j = 0; j < 31; ++j) if (j < tt) hcar = Lv[j] * hcar + Hv[j];
        hin[tid] = hcar; }
    __syncthreads();
    float hi[8];
#pragma unroll
    for (int e = 0; e < 8; ++e) hi[e] = hin[8 * lane + e];
#pragma unroll 8
    for (int rr = 0; rr < 16; ++rr) { const int t = wid + 8 * rr; const size_t row = R0 + t;
        float hl[8], L[8], z[8], hv[8];
        v4u hw; v2u pw; if (t < 16 * PARK_M0) { hw = *(const GAS v4u*)(hloc + row * 512 + 8 * lane); pw = *(const GAS v2u*)(Pbuf + row * 512 + 8 * lane); } else { hw = *(const LAS v4u*)(lds + L_PARKH + (t - 16 * PARK_M0) * 1024 + 16 * lane); pw = *(const LAS v2u*)(lds + L_PARKP + (t - 16 * PARK_M0) * 512 + 8 * lane); }
        unpack8(hw, hl); {
#pragma unroll
            for (int e = 0; e < 8; ++e) L[e] = (float)(((e < 4 ? pw.x : pw.y) >> (8 * (e & 3))) & 0xffu) * (1.0f / 255.0f); } unpack8(*(const GAS v4u*)(proj + (size_t)((OFF_CZ >> 8) + (lane >> 5)) * PTILE + row * 256 + 8 * (lane & 31)), z);
        float ss = 0.f;
#pragma unroll
        for (int e = 0; e < 8; ++e) { hv[e] = hl[e] + L[e] * hi[e]; ss += hv[e] * hv[e]; }
        ss = wave_sum(ss); const float rstd = __builtin_amdgcn_rsqf(ss * (1.0f / 512.0f) + EPS);
#pragma unroll
        for (int e = 0; e < 8; ++e) hv[e] = hv[e] * rstd * silu(z[e]);
        *(GAS v4u*)(ybuf + row * DM + 512 + 8 * lane) = pack8(hv);
    }
    __syncthreads();
}

#define XB_TMO      128
#define XB_XCNT(j)  (256  + 64 * (j))
#define XB_XSUB(j)  (1280 + 64 * (j))
#define XB_XGEN(j)  (2304 + 64 * (j))
#define XB_TOP      3328
#define XB_TOPGEN   3392
#define XCD_BAR_WORDS 3456
#define XB_SPIN_CAP (1u << 18)

__device__ __forceinline__ unsigned xb_ld(unsigned* p)              { return __hip_atomic_load(p, __ATOMIC_RELAXED, __HIP_MEMORY_SCOPE_AGENT); }
__device__ __forceinline__ unsigned xb_add(unsigned* p, unsigned v) { return __hip_atomic_fetch_add(p, v, __ATOMIC_RELAXED, __HIP_MEMORY_SCOPE_AGENT); }
__device__ __forceinline__ unsigned xb_xcc_id() { return (unsigned)__builtin_amdgcn_s_getreg((3 << 11) | 20) & 0xFu; }
#define XB_SPIN(cond, bar) do { unsigned _sp = 0; while (cond) { __builtin_amdgcn_s_sleep(1); \
    if ((++_sp & 255u) == 0u) { if (xb_ld(&(bar)[XB_TMO])) break; if (_sp > XB_SPIN_CAP) { atomicAdd(&(bar)[XB_TMO], 1u); break; } } } } while (0)

struct XcdBarrier {
    unsigned* bar; unsigned x;
    volatile LAS unsigned* st;
};

__device__ __forceinline__ XcdBarrier xcd_barrier_post(unsigned* bar, volatile LAS unsigned* st) {
    XcdBarrier b; b.bar = bar; b.x = xb_xcc_id(); b.st = st;
    if (threadIdx.x == 0) (void)xb_add(&bar[XB_XCNT(b.x)], 1u);
    return b;
}
__device__ __forceinline__ void xcd_barrier_complete(unsigned* bar, unsigned x, unsigned& nloc, unsigned& nx) {
    const unsigned G = gridDim.x * gridDim.y * gridDim.z;
    unsigned sum, cnt, mine, sp = 0u;
    for (;;) {
        sum = 0u; cnt = 0u; mine = 0u;
#pragma unroll
        for (unsigned j = 0; j < 16; ++j) { const unsigned c = xb_ld(&bar[XB_XCNT(j)]); sum += c; cnt += (c > 0u) ? 1u : 0u; mine = (j == x) ? c : mine; }
        if (sum == G) break;
        __builtin_amdgcn_s_sleep(1);
        if ((++sp & 255u) == 0u) { if (xb_ld(&bar[XB_TMO])) break; if (sp > XB_SPIN_CAP) { atomicAdd(&bar[XB_TMO], 1u); break; } }
    }
    nloc = mine > 0u ? mine : 1u; nx = cnt > 0u ? cnt : 1u;
}

__device__ __forceinline__ void xcd_barrier(const XcdBarrier& b) {
    asm volatile("s_waitcnt vmcnt(0)" ::: "memory");
    __syncthreads();
    if (threadIdx.x == 0) {
        unsigned* bar = b.bar;
        __builtin_amdgcn_s_waitcnt(0);
        unsigned nloc = b.st[0], nx = b.st[1];
        if (nloc == 0u) { xcd_barrier_complete(bar, b.x, nloc, nx); b.st[0] = nloc; b.st[1] = nx; }
        const unsigned old = xb_add(&bar[XB_XSUB(b.x)], 1u);
        const unsigned gen = old / nloc;
        if (old + 1u == (gen + 1u) * nloc) {
            __builtin_amdgcn_fence(__ATOMIC_RELEASE, "agent");
            asm volatile("s_waitcnt vmcnt(0)" ::: "memory");
            const unsigned og = xb_add(&bar[XB_TOP], 1u);
            const unsigned tg = og / nx;
            if (og + 1u == (tg + 1u) * nx) xb_add(&bar[XB_TOPGEN], 1u);
            else XB_SPIN(xb_ld(&bar[XB_TOPGEN]) == tg, bar);
            __builtin_amdgcn_fence(__ATOMIC_ACQUIRE, "agent");
            xb_add(&bar[XB_XGEN(b.x)], 1u);
            asm volatile("s_waitcnt vmcnt(0)" ::: "memory");
        } else {
            XB_SPIN(xb_ld(&bar[XB_XGEN(b.x)]) == gen, bar);
            __builtin_amdgcn_fence(__ATOMIC_ACQUIRE, "agent");
            asm volatile("s_waitcnt vmcnt(0)" ::: "memory");
        }
    }
    __syncthreads();
}

#ifndef REP_P0
#define REP_P0 1
#endif
#ifndef REP_P1
#define REP_P1 1
#endif
#ifndef REP_P2
#define REP_P2 1
#endif
#ifndef REP_P3
#define REP_P3 1
#endif
#ifndef REP_C
#define REP_C 1
#endif
#ifndef REP_A
#define REP_A 1
#endif
#ifndef REP_B
#define REP_B 1
#endif
#ifndef REP_F
#define REP_F 1
#endif
typedef __attribute__((address_space(4))) const unsigned long long* kptr_t;
__device__ __forceinline__ unsigned long long karg(int i) { kptr_t k = (kptr_t)__builtin_amdgcn_kernarg_segment_ptr(); asm volatile("" : "+s"(k)); return k[i]; }
#define KIN(i) ((const GAS float*)karg(i))
#define KOUT ((GAS float*)karg(19))
#define KWS ((GAS unsigned char*)karg(20))

__global__ void __launch_bounds__(NTHR, 2) hybrid_fwd(Params p) {
    extern __shared__ __attribute__((aligned(16))) unsigned char lds_raw[];
    cg::grid_group grid = cg::this_grid();
    LAS unsigned char* lds = (LAS unsigned char*)lds_raw;
    if (threadIdx.x < 16) ((LAS unsigned*)(lds + L_MISC))[threadIdx.x] = 0u;
    __syncthreads();
    const XcdBarrier bar = xcd_barrier_post((unsigned*)(KWS + WS_CTL), (volatile LAS unsigned*)(lds + L_MISC));
    if (gridDim.x == 0x7fffffffu) grid.sync();
#define GRID_BAR() xcd_barrier(bar)
#ifdef TS_A
#define STAMP(k) do { if (threadIdx.x == 0) ((volatile LAS unsigned*)(lds + L_MISC))[2 + (k)] = (unsigned)__builtin_amdgcn_s_memrealtime(); } while (0)
#else
#define STAMP(k) do {} while (0)
#endif
    STAMP(0);
#ifndef NO_P0
    for (int rep0 = 0; rep0 < REP_P0; ++rep0)
    { int tid = threadIdx.x; asm volatile("" : "+v"(tid)); p0_prologue(p, lds, tid, tid & 63, __builtin_amdgcn_readfirstlane(tid >> 6)); }
#endif
    GRID_BAR();
    STAMP(1);
#pragma unroll 1
    for (int l = 0; l < 2; ++l) {
#ifndef NO_P1
        for (int rep1 = 0; rep1 < REP_P1; ++rep1)
        {
            GAS unsigned char* ws = KWS;
            pg8::Gemm g{(const bf16*)(ws + WS_H), (const bf16*)(ws + WS_WIN) + (size_t)l * DIN * DM, MROWS, DIN, DM};
            pg8::EpiProj E{(GAS bf16*)(ws + WS_PROJ), (const GAS float*)(ws + WS_ROWSS) + l * MROWS, DIN};
            if (l == 0 && gridDim.x == 256) {
                if (blockIdx.x >= 128) { int td = threadIdx.x; asm volatile("" : "+v"(td)); p0b_convert(KIN(0), ws, (int)blockIdx.x - 128, td & 63, __builtin_amdgcn_readfirstlane(td >> 6)); }
                else { int td = threadIdx.x; asm volatile("" : "+v"(td)); p0_deferred(KIN(2) + (size_t)DM * DIN, KIN(1) + DM, KIN(17), KIN(16), ws, lds, 0, 128, td & 63, __builtin_amdgcn_readfirstlane(td >> 6)); }
                __syncthreads();
                pg8::PanelOrder S{(int)blockIdx.x, (const unsigned*)(ws + WS_CTL + CTL_READY), 8u};
                pg8::gemm_phase<pg8::EpiProj, pg8::PanelOrder, true, true>(lds, g, S, E);
            } else { pg8::StaticOrder S; S.init(MROWS, DIN, gridDim.x, (int)blockIdx.x);
                pg8::gemm_phase<pg8::EpiProj, pg8::StaticOrder, true, true>(lds, g, S, E); }
        }
#endif
        GRID_BAR();
        if (l == 0) STAMP(2);
#ifndef NO_P2
        for (int rep2 = 0; rep2 < REP_P2; ++rep2)
        for (int T = blockIdx.x; T < NTILES; T += gridDim.x) {
            int tid = threadIdx.x; asm volatile("" : "+v"(tid)); const int lane = tid & 63, wave = __builtin_amdgcn_readfirstlane(tid >> 6);
            GAS unsigned char* ws = KWS; const GAS bf16* proj = (const GAS bf16*)(ws + WS_PROJ); GAS bf16* ybuf = (GAS bf16*)(ws + WS_Y);
            GAS bf16* hloc = (GAS bf16*)(ws + WS_SCAN); GAS float* aggL = (GAS float*)(ws + WS_AGG); GAS unsigned* flags = (GAS unsigned*)(ws + WS_CTL + CTL_FLAGS) + l * NTILES * 16;
            mixer_c(lds, proj, (const GAS bf16*)(ws + WS_WA) + l * 8 * 4096, (const GAS bf16*)(ws + WS_WX) + l * 8 * 4096, KIN(9) + l * 4 * 512, KIN(10) + l * 512,
                    KIN(12) + l * 512, KIN(14) + l * 512, KIN(15) + l * 512, hloc, (GAS unsigned char*)(hloc + (size_t)MROWS * 512), aggL, aggL + NTILES * 512, T, wave, lane);
            __syncthreads();
            if (l == 0) STAMP(3);
            if (tid == 0) __hip_atomic_store(flags + 16 * T, 1u, __ATOMIC_RELAXED, __HIP_MEMORY_SCOPE_AGENT);
            p3_tile(lds, proj, hloc, (const GAS unsigned char*)(hloc + (size_t)MROWS * 512), aggL, aggL + NTILES * 512, flags, ybuf, T, tid, wave, lane);
            mixer_a(lds, proj, (const GAS bf16*)(ws + WS_SGUW) + l * 4 * 128 * 128, KIN(3) + l * 256, KIN(5) + l * 512, ybuf, T, tid, wave, lane);
            mixer_b(lds, proj, (const GAS bf16*)(ws + WS_POOLW) + l * 4 * 4096, KIN(7) + l * 256, KIN(8) + l * 256, ybuf, T, tid, wave, lane);
            __syncthreads();
        }
#endif
#ifdef TS_A
        if (l == 1 && blockIdx.x == 0 && threadIdx.x == 0) { volatile LAS unsigned* st = (volatile LAS unsigned*)(lds + L_MISC) + 2; *(unsigned*)(KWS + WS_CTL + CTL_DBG) = st[TS_B] - st[TS_A]; }
#endif
        GRID_BAR();
        if (l == 0) STAMP(7);
#ifndef NO_P4
        {
            GAS unsigned char* ws = KWS; GAS float* out = KOUT;
            pg8::Gemm g{(const bf16*)(ws + WS_Y), (const bf16*)(ws + WS_WOUT) + (size_t)l * DM * DM, MROWS, DM, DM}; pg8::StaticOrder S; S.init(MROWS, DM, gridDim.x, (int)blockIdx.x);
            if (l == 0) { pg8::EpiOut E{(GAS bf16*)(ws + WS_H), (GAS float*)(ws + WS_ROWSS) + MROWS};
                pg8::gemm_phase<pg8::EpiOut, pg8::StaticOrder, true, true>(lds, g, S, E); }
            else { pg8::EpiOutFinal E{(const GAS bf16*)(ws + WS_H), out, (GAS float*)(ws + WS_ROWSS) + 2 * MROWS, (GAS unsigned*)(ws + WS_CTL + CTL_PANEL), KIN(18), (const GAS unsigned*)(ws + WS_CTL + CTL_DBG)};
                pg8::gemm_phase<pg8::EpiOutFinal, pg8::StaticOrder, true, true>(lds, g, S, E); }
        }
#endif
        if (l == 0) { GRID_BAR(); STAMP(8); }
    }
}

extern "C" void kernel_launch(void* const* d_in, const int* in_sizes, int n_in, void* d_out, int out_size, void* d_ws, size_t ws_size, hipStream_t stream) {
    static int grid = 0;
    if (grid == 0) {
        int dev = 0, cus = 0, per_cu = 0;
        if (n_in != 19 || out_size != MROWS * DM || ws_size < WS_END) { fprintf(stderr, "kernel_launch: unexpected shapes (n_in %d out %d ws %zu)\n", n_in, out_size, ws_size); grid = -1; return; }
        hipGetDevice(&dev); hipDeviceGetAttribute(&cus, hipDeviceAttributeMultiprocessorCount, dev);
        if (hipFuncSetAttribute((const void*)hybrid_fwd, hipFuncAttributeMaxDynamicSharedMemorySize, LDS_BYTES) != hipSuccess) { fprintf(stderr, "kernel_launch: hipFuncSetAttribute failed\n"); }
        if (hipOccupancyMaxActiveBlocksPerMultiprocessor(&per_cu, (const void*)hybrid_fwd, NTHR, LDS_BYTES) != hipSuccess || per_cu < 1) per_cu = 1;
        (void)hipGetLastError();
        if (per_cu > 1) per_cu = 1;
        grid = cus * per_cu;
        if (grid < 1) grid = 256;
        if (grid != 256) { fprintf(stderr, "kernel_launch: built for a 256-CU device (one workgroup per CU); got a grid of %d, nothing launched\n", grid); grid = -1; return; }
    }
    if (grid < 0) return;
    Params p{};
    for (int i = 0; i < 19; ++i) p.in[i] = (const float*)d_in[i];
    p.out = (float*)d_out; p.ws = (unsigned char*)d_ws;
    if (hipMemsetAsync((char*)d_ws + WS_CTL, 0, CTL_BYTES, stream) != hipSuccess) { fprintf(stderr, "kernel_launch: memset failed\n"); return; }
    void* args[] = {&p};
    hipError_t e = hipLaunchCooperativeKernel((const void*)hybrid_fwd, dim3(grid), dim3(NTHR), args, LDS_BYTES, stream);
    if (e != hipSuccess) fprintf(stderr, "kernel_launch: cooperative launch failed: %s (grid %d)\n", hipGetErrorString(e), grid);
}
```

```cpp
#include <hip/hip_runtime.h>
#include <hip/hip_cooperative_groups.h>
#include <cstdio>
#include <cstdint>
namespace cg = cooperative_groups;
namespace pg8 {
#define PG8_LAS __attribute__((address_space(3)))
typedef unsigned short bf16_t;
typedef short bf16x8 __attribute__((ext_vector_type(8)));
typedef float f32x4 __attribute__((ext_vector_type(4)));
typedef unsigned u32x4 __attribute__((ext_vector_type(4)));
constexpr int BM = 256, BK = 64, HALF = 128, HTB = HALF * BK * 2  , STAGE_BYTES = 8 * HTB, NXCD = 8, WGM = 8;

__host__ __device__ __forceinline__ int lds_byte(int r, int c) { const int st = (r >> 4) * 2 + (c >> 5), rr = r & 15, cc = c & 31, ob = rr * 64 + cc * 2; return st * 1024 + (ob ^ (((ob >> 9) & 1) << 5)); }
__host__ __device__ __forceinline__ void stage_rc(int b, int& R, int& C) { const int st = b / 1024, sb = b % 1024, swz = sb ^ (((sb >> 9) & 1) << 5); R = (st >> 1) * 16 + swz / 64; C = (st & 1) * 32 + (swz % 64) / 2; }
__host__ __device__ __forceinline__ int perm32(int rho) { const int n = rho >> 4, i = rho & 15; return 8 * (i >> 2) + 4 * n + (i & 3); }

struct Unit { int pm, pn; };
struct Gemm { const bf16_t* A; const bf16_t* Bt; int M, N, K; };

struct StaticOrder {
    int nM, nN, nwg, G, c;
    __host__ __device__ void init(int M, int N, int G_, int c_) { nM = M / BM; nN = N / BM; nwg = nM * nN; G = G_; c = c_; }
    __host__ __device__ bool next(int i, Unit& u) const {
        const long L = (long)i * G + c; if (L >= nwg) return false;
        int wgid = (int)L; { const int q = nwg / NXCD, r = nwg % NXCD, xcd = wgid % NXCD, off = wgid / NXCD; wgid = (xcd < r ? xcd * (q + 1) : r * (q + 1) + (xcd - r) * q) + off; }
        const int nig = WGM * nN, gid = wgid / nig, fm = gid * WGM, gsz = (nM - fm) < WGM ? (nM - fm) : WGM;
        u.pm = fm + ((wgid % nig) % gsz); u.pn = (wgid % nig) / gsz; return true;
    }
    __device__ __forceinline__ void a_ready(const Unit&) const {}
    __device__ __forceinline__ void done(const Unit&) const {}
};
struct PanelOrder {
    int c; const unsigned* ready; unsigned need;
    __device__ bool next(int i, Unit& u) const {
        const int late = c >> 7, cc = c & 127;
        int base;
        if (!late) { if (i > 4) return false; base = (i == 0) ? 0 : (i == 1) ? 128 : (i == 2) ? 384 : (i == 3) ? 640 : 896; }
        else { if (i > 3) return false; base = 256 + 256 * i; }
        const int U = base + cc, chunk = U / 288, s = U - 288 * chunk;
        const int wgid = (s & 7) * 36 + (s >> 3), gid = wgid / 72, w = wgid - 72 * gid;
        u.pm = 32 * chunk + 8 * gid + (w & 7); u.pn = w >> 3; return true;
    }
    __device__ __forceinline__ void a_ready(const Unit& u) const {
        if (threadIdx.x < 64) {
            unsigned sp = 0;
            while ((unsigned)__builtin_amdgcn_readfirstlane(__hip_atomic_load(ready + 64 * u.pm, __ATOMIC_RELAXED, __HIP_MEMORY_SCOPE_AGENT)) < need) { __builtin_amdgcn_s_sleep(2); if (++sp > (1u << 22)) break; }
            __builtin_amdgcn_fence(__ATOMIC_ACQUIRE, "agent");
            asm volatile("s_waitcnt vmcnt(0)" ::: "memory");
        }
        asm volatile("" ::: "memory"); __builtin_amdgcn_s_barrier(); asm volatile("" ::: "memory");
    }
    __device__ __forceinline__ void done(const Unit&) const {}
};

#if defined(__HIP_DEVICE_COMPILE__)
#define PG8_GAS __attribute__((address_space(1)))
#else
#define PG8_GAS
#endif
__device__ __forceinline__ unsigned cvt_pk_bf16(float lo, float hi) { unsigned r; asm volatile("v_cvt_pk_bf16_f32 %0, %1, %2" : "=v"(r) : "v"(lo), "v"(hi)); return r; }

struct EpiProj {
    static constexpr bool PERM = true, AFTER_DRAIN = false;
    PG8_GAS bf16_t* O; const PG8_GAS float* rowss; int ldc;
    __device__ __forceinline__ void operator()(const f32x4 (&acc)[2][2][4][2], const Unit& u, int wr, int wc, int fr, int fq) const {
        const int row0 = u.pm * BM + wr * 64 + fr, col0 = u.pn * BM + wc * 32 + 8 * fq;
#pragma unroll
        for (int ai = 0; ai < 2; ++ai)
#pragma unroll
            for (int m = 0; m < 4; ++m) {
                const int row = row0 + ai * HALF + m * 16;
                const float rs = __builtin_amdgcn_rsqf(rowss[row] * (1.0f / 1024.0f) + 1e-6f);
                PG8_GAS bf16_t* rowp = O + ((size_t)u.pn * 32768 + row) * 256 + (col0 - u.pn * BM);
#pragma unroll
                for (int bj = 0; bj < 2; ++bj) { const f32x4 v0 = acc[ai][bj][m][0] * rs, v1 = acc[ai][bj][m][1] * rs;
                    u32x4 w; w.x = cvt_pk_bf16(v0[0], v0[1]); w.y = cvt_pk_bf16(v0[2], v0[3]); w.z = cvt_pk_bf16(v1[0], v1[1]); w.w = cvt_pk_bf16(v1[2], v1[3]);
                    *(PG8_GAS u32x4*)(rowp + bj * HALF) = w; }
            }
    }
};
struct EpiOut {
    static constexpr bool PERM = true, AFTER_DRAIN = false;
    PG8_GAS bf16_t* hb; PG8_GAS float* rowss;
    __device__ __forceinline__ void operator()(const f32x4 (&acc)[2][2][4][2], const Unit& u, int wr, int wc, int fr, int fq) const {
        const int row0 = u.pm * BM + wr * 64 + fr, col0 = u.pn * BM + wc * 32 + 8 * fq;
#pragma unroll
        for (int ai = 0; ai < 2; ++ai) {
            u32x4 rw[4][2];
#pragma unroll
            for (int m = 0; m < 4; ++m)
#pragma unroll
                for (int bj = 0; bj < 2; ++bj) rw[m][bj] = *(const PG8_GAS u32x4*)(hb + (size_t)(row0 + ai * HALF + m * 16) * 1024 + col0 + bj * HALF);
#pragma unroll
            for (int m = 0; m < 4; ++m) {
                const int row = row0 + ai * HALF + m * 16;
                const size_t off = (size_t)row * 1024 + col0;
                float ss = 0.f;
#pragma unroll
                for (int bj = 0; bj < 2; ++bj) {
                    const u32x4 w0 = rw[m][bj];
                    const f32x4 r0 = {__uint_as_float(w0.x << 16), __uint_as_float(w0.x & 0xffff0000u), __uint_as_float(w0.y << 16), __uint_as_float(w0.y & 0xffff0000u)};
                    const f32x4 r1 = {__uint_as_float(w0.z << 16), __uint_as_float(w0.z & 0xffff0000u), __uint_as_float(w0.w << 16), __uint_as_float(w0.w & 0xffff0000u)};
                    const f32x4 v0 = acc[ai][bj][m][0] + r0, v1 = acc[ai][bj][m][1] + r1;
                    ss += (v0[0] * v0[0] + v0[1] * v0[1]) + (v0[2] * v0[2] + v0[3] * v0[3]) + (v1[0] * v1[0] + v1[1] * v1[1]) + (v1[2] * v1[2] + v1[3] * v1[3]);
                    u32x4 w; w.x = cvt_pk_bf16(v0[0], v0[1]); w.y = cvt_pk_bf16(v0[2], v0[3]); w.z = cvt_pk_bf16(v1[0], v1[1]); w.w = cvt_pk_bf16(v1[2], v1[3]);
                    *(PG8_GAS u32x4*)(hb + off + bj * HALF) = w;
                }
                ss += __shfl_xor(ss, 16); ss += __shfl_xor(ss, 32);
                if (fq == 0) __hip_atomic_fetch_add(rowss + row, ss, __ATOMIC_RELAXED, __HIP_MEMORY_SCOPE_AGENT);
            }
        }
    }
};
struct EpiOutFinal {
    static constexpr bool PERM = true, AFTER_DRAIN = false;
    const PG8_GAS bf16_t* resid; PG8_GAS float* out; PG8_GAS float* rowss; PG8_GAS unsigned* cnt; const PG8_GAS float* fg; const PG8_GAS unsigned* dbg;
    __device__ __forceinline__ void operator()(f32x4 (&acc)[2][2][4][2], const Unit& u, int wr, int wc, int fr, int fq) const {
        const int row0 = u.pm * BM + wr * 64 + fr, col0 = u.pn * BM + wc * 32 + 8 * fq;
#pragma unroll
        for (int am = 0; am < 4; ++am) { const int ai = am >> 1;
            f32x4 r[4][2][2];
#pragma unroll
            for (int m = 2 * (am & 1); m < 2 * (am & 1) + 2; ++m)
#pragma unroll
                for (int bj = 0; bj < 2; ++bj) { const size_t off = (size_t)(row0 + ai * HALF + m * 16) * 1024 + col0 + bj * HALF;
                    const u32x4 w = *(const PG8_GAS u32x4*)(resid + off);
                    r[m][bj][0] = (f32x4){__uint_as_float(w.x << 16), __uint_as_float(w.x & 0xffff0000u), __uint_as_float(w.y << 16), __uint_as_float(w.y & 0xffff0000u)};
                    r[m][bj][1] = (f32x4){__uint_as_float(w.z << 16), __uint_as_float(w.z & 0xffff0000u), __uint_as_float(w.w << 16), __uint_as_float(w.w & 0xffff0000u)}; }
#pragma unroll
            for (int m = 2 * (am & 1); m < 2 * (am & 1) + 2; ++m) {
                const int row = row0 + ai * HALF + m * 16;
                float ss = 0.f;
#pragma unroll
                for (int bj = 0; bj < 2; ++bj) {
                    const f32x4 v0 = acc[ai][bj][m][0] + r[m][bj][0], v1 = acc[ai][bj][m][1] + r[m][bj][1];
                    acc[ai][bj][m][0] = v0; acc[ai][bj][m][1] = v1;
                    ss += (v0[0] * v0[0] + v0[1] * v0[1]) + (v0[2] * v0[2] + v0[3] * v0[3]) + (v1[0] * v1[0] + v1[1] * v1[1]) + (v1[2] * v1[2] + v1[3] * v1[3]);
                }
                ss += __shfl_xor(ss, 16); ss += __shfl_xor(ss, 32);
                if (fq == 0) __hip_atomic_fetch_add(rowss + row, ss, __ATOMIC_RELAXED, __HIP_MEMORY_SCOPE_AGENT);
            }
        }
        asm volatile("s_waitcnt vmcnt(0)" ::: "memory");
        PG8_GAS unsigned* c = cnt + 64 * u.pm;
        if ((threadIdx.x & 63) == 0) __hip_atomic_fetch_add(c, 1u, __ATOMIC_RELAXED, __HIP_MEMORY_SCOPE_AGENT);
        { unsigned sp = 0; while ((unsigned)__builtin_amdgcn_readfirstlane(__hip_atomic_load(c, __ATOMIC_RELAXED, __HIP_MEMORY_SCOPE_AGENT)) < 32u) { __builtin_amdgcn_s_sleep(2); if (++sp > (1u << 22)) break; } }
        asm volatile("" ::: "memory");
        f32x4 g0[2], g1[2];
#ifdef TS_A
        const float dlt = (float)dbg[0] * 1e-7f;
#else
        const float dlt = 0.f;
#endif
#pragma unroll
        for (int bj = 0; bj < 2; ++bj) { g0[bj] = *(const PG8_GAS f32x4*)(fg + col0 + bj * HALF); g1[bj] = *(const PG8_GAS f32x4*)(fg + col0 + bj * HALF + 4); }
#pragma unroll
        for (int ai = 0; ai < 2; ++ai)
#pragma unroll
            for (int m = 0; m < 4; ++m) {
                const int row = row0 + ai * HALF + m * 16;
                const float rs = __builtin_amdgcn_rsqf(__hip_atomic_load(rowss + row, __ATOMIC_RELAXED, __HIP_MEMORY_SCOPE_AGENT) * (1.0f / 1024.0f) + 1e-6f);
                PG8_GAS float* o = out + (size_t)row * 1024 + col0;
#pragma unroll
                for (int bj = 0; bj < 2; ++bj) { *(PG8_GAS f32x4*)(o + bj * HALF) = acc[ai][bj][m][0] * rs * g0[bj] + dlt; *(PG8_GAS f32x4*)(o + bj * HALF + 4) = acc[ai][bj][m][1] * rs * g1[bj] + dlt; }
            }
    }
};

template <class Epi, class Sched, bool ALIGN_EPI = false, bool SP2 = false>
__device__ __forceinline__ void gemm_phase(PG8_LAS unsigned char* lds, const Gemm g, const Sched& S, const Epi& E) {
    int tid_ = threadIdx.x; asm volatile("" : "+v"(tid_));
    const int tid = tid_, wid = __builtin_amdgcn_readfirstlane(tid >> 6), lane = tid & 63, wr = wid >> 2, wc = wid & 3, fr = lane & 15, fq = lane >> 4;
    const int K = g.K, nt = K / BK;
    unsigned voffA[2], voffB[2];
#pragma unroll
    for (int i = 0; i < 2; ++i) { int R, C; stage_rc(tid * 16 + i * 8192, R, C); const int Rb = Epi::PERM ? ((R & ~31) + perm32(R & 31)) : R;
        voffA[i] = (unsigned)(R * K + C) * 2u; voffB[i] = (unsigned)(Rb * K + C) * 2u; }
    const size_t kstep = (size_t)(BK * 2);
    const size_t hstep = (size_t)HALF * K * 2;
    const size_t tstep = 2 * hstep;
    const unsigned ldsw = (unsigned)wid * 1024u;
    const int aoff = lds_byte(wr * 64 + fr, fq * 8), boff = lds_byte(wc * 32 + fr, fq * 8);
#define PG8_SA(b, h) (((b) * 2 + (h)) * HTB)
#define PG8_SB(b, h) ((4 + (b) * 2 + (h)) * HTB)
#define PG8_STAGE(bufoff, gbase, voff) do { _Pragma("unroll") for (int _i = 0; _i < 2; ++_i) \
        __builtin_amdgcn_global_load_lds((const unsigned*)((const char*)(gbase) + (voff)[_i]), (PG8_LAS unsigned*)(lds + (bufoff) + ldsw + _i * 8192), 16, 0, 0); } while (0)
#define PG8_LDA(dst, b, h) do { _Pragma("unroll") for (int m = 0; m < 4; ++m) _Pragma("unroll") for (int k = 0; k < 2; ++k) dst[m][k] = *(const PG8_LAS bf16x8*)(lds + PG8_SA(b, h) + aoff + m * 2048 + k * 1024); } while (0)
#define PG8_LDB(dst, b, h) do { _Pragma("unroll") for (int n = 0; n < 2; ++n) _Pragma("unroll") for (int k = 0; k < 2; ++k) dst[n][k] = *(const PG8_LAS bf16x8*)(lds + PG8_SB(b, h) + boff + n * 2048 + k * 1024); } while (0)
#define PG8_MMA(ai, bj, At, Bt) do { __builtin_amdgcn_s_setprio(1); _Pragma("unroll") for (int m = 0; m < 4; ++m) _Pragma("unroll") for (int n = 0; n < 2; ++n) _Pragma("unroll") for (int k = 0; k < 2; ++k) \
        acc[ai][bj][m][n] = __builtin_amdgcn_mfma_f32_16x16x32_bf16(Bt[n][k], At[m][k], acc[ai][bj][m][n], 0, 0, 0); __builtin_amdgcn_s_setprio(0); } while (0)
#define PG8_WAIT_V(n) asm volatile("s_waitcnt vmcnt(" #n ")" ::: "memory")
#define PG8_WAIT_L(n) asm volatile("s_waitcnt lgkmcnt(" #n ")" ::: "memory")
#define PG8_BAR __builtin_amdgcn_s_barrier()
#define PG8_SCHED __builtin_amdgcn_sched_barrier(0)
    Unit cur, nxt; int ui = 0;
    if (!S.next(0, cur)) return;
    f32x4 acc[2][2][4][2];
#pragma unroll
    for (int a = 0; a < 2; ++a)
#pragma unroll
        for (int b = 0; b < 2; ++b)
#pragma unroll
            for (int m = 0; m < 4; ++m)
#pragma unroll
                for (int n = 0; n < 2; ++n) acc[a][b][m][n] = (f32x4){0.f, 0.f, 0.f, 0.f};
    bf16x8 At[4][2], B0[2][2], B1[2][2];
    const char* cA = (const char*)g.A + (size_t)cur.pm * tstep; const char* cB = (const char*)g.Bt + (size_t)cur.pn * tstep;
    S.a_ready(cur);
    if constexpr (SP2) {
        PG8_STAGE(PG8_SB(0, 0), cB, voffB); PG8_STAGE(PG8_SB(0, 1), cB + hstep, voffB); PG8_STAGE(PG8_SA(0, 0), cA, voffA); PG8_STAGE(PG8_SA(0, 1), cA + hstep, voffA);
        if (wr == 1) PG8_BAR;
        PG8_WAIT_V(2); PG8_BAR;
        PG8_STAGE(PG8_SB(1, 0), cB + kstep, voffB); PG8_STAGE(PG8_SA(1, 0), cA + kstep, voffA); PG8_STAGE(PG8_SB(1, 1), cB + hstep + kstep, voffB);
        PG8_WAIT_V(6); PG8_BAR;
    } else {
        PG8_STAGE(PG8_SB(0, 0), cB, voffB); PG8_STAGE(PG8_SA(0, 0), cA, voffA); PG8_STAGE(PG8_SB(0, 1), cB + hstep, voffB); PG8_STAGE(PG8_SA(0, 1), cA + hstep, voffA);
        if (wr == 1) PG8_BAR;
        PG8_WAIT_V(4); PG8_BAR;
        PG8_STAGE(PG8_SB(1, 0), cB + kstep, voffB); PG8_STAGE(PG8_SA(1, 0), cA + kstep, voffA); PG8_STAGE(PG8_SB(1, 1), cB + hstep + kstep, voffB);
        PG8_WAIT_V(6); PG8_BAR;
    }
    for (;;) {
        const bool has_next = S.next(ui + 1, nxt);
        const char* nA = has_next ? (const char*)g.A + (size_t)nxt.pm * tstep : cA; const char* nB = has_next ? (const char*)g.Bt + (size_t)nxt.pn * tstep : cB;
        for (int t = 0; t < nt; t += 2) {
            const bool last = (t == nt - 2);
            const char* a1 = cA + (size_t)(t + 1) * kstep;
            const char* a2 = last ? nA : cA + (size_t)(t + 2) * kstep; const char* b2 = last ? nB : cB + (size_t)(t + 2) * kstep;
            const char* a3 = a2 + kstep; const char* b3 = b2 + kstep;
            if (last && has_next) S.a_ready(nxt);
            if constexpr (SP2) {
            PG8_LDB(B0, 0, 0); PG8_LDB(B1, 0, 1); PG8_SCHED; PG8_LDA(At, 0, 0); PG8_STAGE(PG8_SA(1, 1), a1 + hstep, voffA);
            PG8_WAIT_V(8); PG8_WAIT_L(0); PG8_BAR; PG8_MMA(0, 0, At, B0); PG8_MMA(0, 1, At, B1); PG8_BAR; PG8_SCHED;
            PG8_LDA(At, 0, 1); PG8_STAGE(PG8_SB(0, 0), b2, voffB); PG8_STAGE(PG8_SB(0, 1), b2 + hstep, voffB); PG8_STAGE(PG8_SA(0, 0), a2, voffA);
            PG8_WAIT_V(8); PG8_WAIT_L(0); PG8_BAR; PG8_MMA(1, 0, At, B0); PG8_MMA(1, 1, At, B1); PG8_BAR; PG8_SCHED;
            PG8_LDB(B0, 1, 0); PG8_LDB(B1, 1, 1); PG8_SCHED; PG8_LDA(At, 1, 0); PG8_STAGE(PG8_SA(0, 1), a2 + hstep, voffA);
            PG8_WAIT_V(8); PG8_WAIT_L(0); PG8_BAR; PG8_MMA(0, 0, At, B0); PG8_MMA(0, 1, At, B1); PG8_BAR; PG8_SCHED;
            PG8_LDA(At, 1, 1); PG8_STAGE(PG8_SB(1, 0), b3, voffB); PG8_STAGE(PG8_SB(1, 1), b3 + hstep, voffB); PG8_STAGE(PG8_SA(1, 0), a3, voffA);
            PG8_WAIT_V(8); PG8_WAIT_L(0); PG8_BAR; PG8_MMA(1, 0, At, B0); PG8_MMA(1, 1, At, B1); PG8_BAR; PG8_SCHED;
            } else {
            PG8_LDB(B0, 0, 0); PG8_SCHED; PG8_LDA(At, 0, 0); PG8_STAGE(PG8_SA(1, 1), a1 + hstep, voffA);
            PG8_WAIT_L(8); PG8_BAR; PG8_WAIT_L(0); PG8_MMA(0, 0, At, B0); PG8_BAR; PG8_SCHED;
            PG8_LDB(B1, 0, 1); PG8_STAGE(PG8_SB(0, 0), b2, voffB);
            PG8_BAR; PG8_WAIT_L(0); PG8_MMA(0, 1, At, B1); PG8_BAR;
            PG8_LDA(At, 0, 1); PG8_STAGE(PG8_SA(0, 0), a2, voffA);
            PG8_BAR; PG8_WAIT_L(0); PG8_MMA(1, 0, At, B0); PG8_BAR; PG8_SCHED;
            PG8_STAGE(PG8_SB(0, 1), b2 + hstep, voffB);
            PG8_WAIT_V(6); PG8_BAR; PG8_MMA(1, 1, At, B1); PG8_BAR;
            PG8_LDB(B0, 1, 0); PG8_SCHED; PG8_LDA(At, 1, 0); PG8_STAGE(PG8_SA(0, 1), a2 + hstep, voffA);
            PG8_WAIT_L(8); PG8_BAR; PG8_WAIT_L(0); PG8_MMA(0, 0, At, B0); PG8_BAR; PG8_SCHED;
            PG8_LDB(B1, 1, 1); PG8_STAGE(PG8_SB(1, 0), b3, voffB);
            PG8_BAR; PG8_WAIT_L(0); PG8_MMA(0, 1, At, B1); PG8_BAR;
            PG8_LDA(At, 1, 1); PG8_STAGE(PG8_SA(1, 0), a3, voffA);
            PG8_BAR; PG8_WAIT_L(0); PG8_MMA(1, 0, At, B0); PG8_BAR; PG8_SCHED;
            PG8_STAGE(PG8_SB(1, 1), b3 + hstep, voffB);
            PG8_WAIT_V(6); PG8_BAR; PG8_MMA(1, 1, At, B1); PG8_BAR;
            }
        }
        if constexpr (ALIGN_EPI) { if (wr == 0) PG8_BAR; }
        if constexpr (!Epi::AFTER_DRAIN) { E(acc, cur, wr, wc, fr, fq); S.done(cur); }
        if (!has_next) break;
#pragma unroll
        for (int a = 0; a < 2; ++a)
#pragma unroll
            for (int b = 0; b < 2; ++b)
#pragma unroll
                for (int m = 0; m < 4; ++m)
#pragma unroll
                    for (int n = 0; n < 2; ++n) acc[a][b][m][n] = (f32x4){0.f, 0.f, 0.f, 0.f};
        cur = nxt; cA = nA; cB = nB; ++ui;
        if constexpr (ALIGN_EPI) { if (wr == 1) PG8_BAR; }
    }
    PG8_WAIT_V(0);
    if constexpr (!ALIGN_EPI) { if (wr == 0) PG8_BAR; }
    PG8_BAR;
    if constexpr (Epi::AFTER_DRAIN) { E.fused(acc, cur, wr, wc, fr, fq, lds, wid, lane); S.done(cur); }
#undef PG8_SA
#undef PG8_SB
#undef PG8_STAGE
#undef PG8_LDA
#undef PG8_LDB
#undef PG8_MMA
#undef PG8_WAIT_V
#undef PG8_WAIT_L
#undef PG8_BAR
#undef PG8_SCHED
}
}

constexpr int NWAVES = 8, NTHR = 512;
constexpr int MROWS = 32768, DM = 1024, DIN = 2304, SEQ = 4096, TILE = 128, NTILES = MROWS / TILE, TPS = SEQ / TILE;
constexpr size_t PTILE = (size_t)MROWS * 256;
constexpr int OFF_AU = 0, OFF_AV = 256, OFF_AZ = 512, OFF_BX = 768, OFF_BZ = 1024, OFF_CX = 1280, OFF_CZ = 1792;
constexpr float EPS = 1e-6f;
constexpr int PRE_PANELS = 32;
constexpr size_t MiB = 1u << 20;
constexpr size_t WS_WIN = 0;
constexpr size_t WS_WOUT = 9 * MiB;
constexpr size_t WS_SGUW = 13 * MiB;
constexpr size_t WS_POOLW = 13 * MiB + 256 * 1024;
constexpr size_t WS_WA = 13 * MiB + 512 * 1024;
constexpr size_t WS_WX = 13 * MiB + 768 * 1024;
constexpr size_t WS_ROWSS = 14 * MiB;
constexpr size_t WS_CTL = 14 * MiB + 512 * 1024, CTL_PANEL = 16384, CTL_FLAGS = 16384 + 32768, CTL_DBG = 16384 + 32768 + 32768, CTL_READY = 16384 + 32768 + 32768 + 256, CTL_BYTES = 16384 + 32768 + 32768 + 256 + 32768;
constexpr size_t WS_AGG = 15 * MiB;
constexpr size_t WS_H = 16 * MiB;
constexpr size_t WS_PROJ = 80 * MiB;
constexpr size_t WS_Y = 224 * MiB;
constexpr size_t WS_SCAN = 288 * MiB;
constexpr size_t WS_END = 352 * MiB;
constexpr int LDS_BYTES = 163840;

#define LAS __attribute__((address_space(3)))
#if defined(__HIP_DEVICE_COMPILE__)
#define GAS __attribute__((address_space(1)))
#else
#define GAS
#endif
typedef unsigned short bf16;
typedef unsigned v4u __attribute__((ext_vector_type(4)));
typedef unsigned v2u __attribute__((ext_vector_type(2)));
typedef float f32x4 __attribute__((ext_vector_type(4)));
typedef short bf16x8 __attribute__((ext_vector_type(8)));
typedef float f32x2 __attribute__((ext_vector_type(2)));

__device__ __forceinline__ unsigned pk2(float lo, float hi) { return pg8::cvt_pk_bf16(lo, hi); }
__device__ __forceinline__ float bflo(unsigned w) { return __uint_as_float(w << 16); }
__device__ __forceinline__ float bfhi(unsigned w) { return __uint_as_float(w & 0xffff0000u); }
__device__ __forceinline__ float bf2f(bf16 b) { return __uint_as_float(((unsigned)b) << 16); }
__device__ __forceinline__ bf16 f2bf(float f) { return (bf16)(pk2(f, 0.f) & 0xffffu); }
__device__ __forceinline__ float fexp(float x) { return __builtin_amdgcn_exp2f(x * 1.4426950408889634f); }
__device__ __forceinline__ float sigm(float x) { return __builtin_amdgcn_rcpf(1.0f + fexp(-x)); }
__device__ __forceinline__ float silu(float x) { return x * sigm(x); }
__device__ __forceinline__ float wave_sum(float v) {
#pragma unroll
    for (int o = 1; o < 64; o <<= 1) v += __shfl_xor(v, o);
    return v;
}
__device__ __forceinline__ void unpack8(const v4u w, float (&x)[8]) {
    x[0] = bflo(w.x); x[1] = bfhi(w.x); x[2] = bflo(w.y); x[3] = bfhi(w.y); x[4] = bflo(w.z); x[5] = bfhi(w.z); x[6] = bflo(w.w); x[7] = bfhi(w.w);
}
__device__ __forceinline__ v4u pack8(const float (&x)[8]) { v4u w; w.x = pk2(x[0], x[1]); w.y = pk2(x[2], x[3]); w.z = pk2(x[4], x[5]); w.w = pk2(x[6], x[7]); return w; }
#define MFMA16(a, b, c) __builtin_amdgcn_mfma_f32_16x16x32_bf16((a), (b), (c), 0, 0, 0)

struct Params {
    const float* in[19];
    float* out; unsigned char* ws;
};

__device__ __forceinline__ void p0_transpose_item(const GAS float* W, const GAS float* gk, int K, int N, GAS bf16* WT, LAS float* scr, int item, int lane) {
    const int nblk = N / 32, kb = item / nblk, nb = item % nblk, k0 = 64 * kb, n0 = 32 * nb;
    float wv[32];
#pragma unroll
    for (int i = 0; i < 32; ++i) { const int kk = 2 * i + (lane >> 5); wv[i] = W[(size_t)(k0 + kk) * N + n0 + (lane & 31)]; }
    const float g0 = gk[k0 + (lane & 31) + 0], g1 = gk[k0 + (lane & 31) + 32];
#pragma unroll
    for (int i = 0; i < 32; ++i) { const int kk = 2 * i + (lane >> 5); const float gsel = __shfl((2 * i < 32) ? g0 : g1, (lane & 32) + ((2 * i + (lane >> 5)) & 31)); scr[kk * 33 + (lane & 31)] = wv[i] * gsel; }
    asm volatile("s_waitcnt lgkmcnt(0)" ::: "memory");
    const int c = lane & 7;
#pragma unroll
    for (int j = 0; j < 4; ++j) { const int n = (lane >> 3) + 8 * j; const LAS float* s = scr + (8 * c) * 33 + n;
        v4u o; o.x = pk2(s[0 * 33], s[1 * 33]); o.y = pk2(s[2 * 33], s[3 * 33]); o.z = pk2(s[4 * 33], s[5 * 33]); o.w = pk2(s[6 * 33], s[7 * 33]);
        *(GAS v4u*)(WT + (size_t)(n0 + n) * K + k0 + 8 * c) = o; }
    asm volatile("s_waitcnt lgkmcnt(0)" ::: "memory");
}
__device__ __forceinline__ void p0_prologue(const Params& p, LAS unsigned char* lds, int tid, int lane, int wave) {
    unsigned char* ws = p.ws;
    LAS float* scr = (LAS float*)(lds + wave * 16384);
    const int G = gridDim.x, gw = blockIdx.x * NWAVES + wave, NGW = G * NWAVES;
    constexpr int I_IN = (DM / 64) * (DIN / 32), I_OUT = (DM / 64) * (DM / 32);
    for (int it = gw; it < I_IN; it += NGW)
        p0_transpose_item((const GAS float*)p.in[2], (const GAS float*)p.in[1], DM, DIN, (GAS bf16*)(ws + WS_WIN), scr, it, lane);
    const int gt = blockIdx.x * NTHR + tid, NGT = G * NTHR;
    for (int i = gt; i < 2 * 4 * 128 * 128; i += NGT) { const int jj = i & 127, ii = (i >> 7) & 127; const float m = ((jj >> 6) <= (ii >> 6)) ? 1.f : 0.f; ((GAS bf16*)(ws + WS_SGUW))[i] = f2bf(p.in[4][i] * m); }
    for (int i = gt; i < 2 * 4 * 64 * 64; i += NGT) { const int ii = i & 63, o = (i >> 6) & 63, lg = i >> 12; ((GAS bf16*)(ws + WS_POOLW))[i] = f2bf(p.in[6][(lg * 64 + ii) * 64 + o]); }
    for (int i = gt; i < 2 * 8 * 64 * 64; i += NGT) { const int ii = i & 63, o = (i >> 6) & 63, lh = i >> 12;
        ((GAS bf16*)(ws + WS_WA))[i] = f2bf(p.in[11][(lh * 64 + ii) * 64 + o]); ((GAS bf16*)(ws + WS_WX))[i] = f2bf(p.in[13][(lh * 64 + ii) * 64 + o]); }
    GAS float* rowss = (GAS float*)(ws + WS_ROWSS);
    for (int i = gt; i < 2 * MROWS; i += NGT) rowss[MROWS + i] = 0.f;
    {   const GAS float* x = (const GAS float*)p.in[0]; GAS bf16* hb = (GAS bf16*)(ws + WS_H);
        for (int m = gw; m < PRE_PANELS * 256; m += 4 * NGW) {
            f32x4 v[4][4];
#pragma unroll
            for (int q = 0; q < 4; ++q) { const int mq = min(m + q * NGW, PRE_PANELS * 256 - 1); const f32x4* xr = (const GAS f32x4*)(x + (size_t)mq * DM) + lane;
#pragma unroll
                for (int j = 0; j < 4; ++j) v[q][j] = __builtin_nontemporal_load(xr + 64 * j); }
#pragma unroll
            for (int q = 0; q < 4; ++q) { const int mq = m + q * NGW; float s = 0.f;
                if (mq < PRE_PANELS * 256) { GAS unsigned long long* o8 = (GAS unsigned long long*)(hb + (size_t)mq * DM) + lane;
#pragma unroll
                    for (int j = 0; j < 4; ++j) { const f32x4 w = v[q][j]; s += (w.x * w.x + w.y * w.y) + (w.z * w.z + w.w * w.w); o8[64 * j] = (unsigned long long)pk2(w.x, w.y) | ((unsigned long long)pk2(w.z, w.w) << 32); }
                    s = wave_sum(s);
                    if (lane == 0) rowss[mq] = s; } }
        }
        if (blockIdx.x == 0 && tid < PRE_PANELS) __hip_atomic_store((GAS unsigned*)(ws + WS_CTL + CTL_READY) + 64 * tid, 8u, __ATOMIC_RELAXED, __HIP_MEMORY_SCOPE_AGENT);
    }
}
__device__ __forceinline__ void p0b_convert(const GAS float* x, GAS unsigned char* ws, int lb, int lane, int wave) {
    GAS bf16* hb = (GAS bf16*)(ws + WS_H); GAS float* rowss = (GAS float*)(ws + WS_ROWSS); GAS unsigned* ready = (GAS unsigned*)(ws + WS_CTL + CTL_READY);
    const int q = lb >> 3, mem = lb & 7;
#pragma unroll 1
    for (int k = PRE_PANELS / 16; k < 8; ++k) {
        const int pnl = 16 * k + q; const size_t r0 = (size_t)pnl * 256 + 32 * mem + 4 * wave;
        f32x4 v[4][4];
#pragma unroll
        for (int qq = 0; qq < 4; ++qq) { const f32x4* xr = (const GAS f32x4*)(x + (r0 + qq) * DM) + lane;
#pragma unroll
            for (int j = 0; j < 4; ++j) v[qq][j] = __builtin_nontemporal_load(xr + 64 * j); }
#pragma unroll
        for (int qq = 0; qq < 4; ++qq) { float s = 0.f; GAS unsigned long long* o8 = (GAS unsigned long long*)(hb + (r0 + qq) * DM) + lane;
#pragma unroll
            for (int j = 0; j < 4; ++j) { const f32x4 w = v[qq][j]; s += (w.x * w.x + w.y * w.y) + (w.z * w.z + w.w * w.w);
                __hip_atomic_store(o8 + 64 * j, (unsigned long long)pk2(w.x, w.y) | ((unsigned long long)pk2(w.z, w.w) << 32), __ATOMIC_RELAXED, __HIP_MEMORY_SCOPE_AGENT); }
            s = wave_sum(s);
            if (lane == 0) __hip_atomic_store(rowss + r0 + qq, s, __ATOMIC_RELAXED, __HIP_MEMORY_SCOPE_AGENT); }
        asm volatile("s_waitcnt vmcnt(0)" ::: "memory");
        __syncthreads();
        if (threadIdx.x == 0) __hip_atomic_fetch_add(ready + 64 * pnl, 1u, __ATOMIC_RELAXED, __HIP_MEMORY_SCOPE_AGENT);
    }
}

__device__ __forceinline__ void p0_deferred(const GAS float* w_in1, const GAS float* g1, const GAS float* w_out, const GAS float* bg, GAS unsigned char* ws, LAS unsigned char* lds, int first, int nb, int lane, int wave) {
    LAS float* scr = (LAS float*)(lds + wave * 16384);
    const int gw = ((int)blockIdx.x - first) * NWAVES + wave, NGW = nb * NWAVES;
    constexpr int I_IN = (DM / 64) * (DIN / 32), I_OUT = (DM / 64) * (DM / 32);
    for (int it = gw; it < I_IN + 2 * I_OUT; it += NGW) {
        int r = it;
        if (r < I_IN) { p0_transpose_item(w_in1, g1, DM, DIN, (GAS bf16*)(ws + WS_WIN) + (size_t)DIN * DM, scr, r, lane); continue; }
        r -= I_IN; { const int l = r / I_OUT; r -= l * I_OUT;
            p0_transpose_item(w_out + (size_t)l * DM * DM, bg + l * DM, DM, DM, (GAS bf16*)(ws + WS_WOUT) + (size_t)l * DM * DM, scr, r, lane); }
    }
}

static_assert(36864 + 16 * (8 - 3) * 1536 <= 163840 - 64, "parked scan rows fit in LDS");
constexpr int PARK_M0 = 3, PARK_ROWS = 16 * (8 - PARK_M0), L_PARKH = 36864, L_PARKP = L_PARKH + PARK_ROWS * 1024, L_YT = 73728, L_RSTDV = L_YT + 67584, L_HIN = 0, L_MISC = LDS_BYTES - 64;

__device__ __forceinline__ void mixer_c(LAS unsigned char* lds, const GAS bf16* proj, const GAS bf16* waT, const GAS bf16* wxT, const GAS float* conv_w, const GAS float* conv_b,
                                        const GAS float* lba, const GAS float* lbx, const GAS float* lam, GAS bf16* hloc, GAS unsigned char* Pbuf, GAS float* aggL, GAS float* aggH, int T, int wid, int lane) {
    const int h = wid, g = lane >> 4, o = lane & 15, tt = T % TPS;
    const size_t R0 = (size_t)T * TILE;
    LAS unsigned char* cimg = lds + wid * 4608;
    bf16x8 WA[4][2], WX[4][2];
#pragma unroll
    for (int n = 0; n < 4; ++n)
#pragma unroll
        for (int kk = 0; kk < 2; ++kk) { const int idx = (h * 64 + 16 * n + o) * 64 + 32 * kk + 8 * g; WA[n][kk] = *(const GAS bf16x8*)(waT + idx); WX[n][kk] = *(const GAS bf16x8*)(wxT + idx); }
    float nba[4], nbx[4], psp[4], pspl[4], hc[4], Pc[4];
#pragma unroll
    for (int n = 0; n < 4; ++n) { const int c = 64 * h + 16 * n + o; nba[n] = -1.4426950408889634f * lba[c]; nbx[n] = -1.4426950408889634f * lbx[c];
        const float xm = -lam[c]; psp[n] = -8.0f * (fmaxf(xm, 0.f) + log1pf(expf(-fabsf(xm)))); pspl[n] = psp[n] * 1.4426950408889634f; hc[n] = 0.f; Pc[n] = 1.0f; }
#pragma unroll 1
    for (int half = 0; half < 4; ++half) {
        {
            const int oc = lane & 15, seg = lane >> 4, cc = 64 * h + 4 * oc;
            f32x4 cw0 = *(const GAS f32x4*)(conv_w + cc), cw1 = *(const GAS f32x4*)(conv_w + 512 + cc), cw2 = *(const GAS f32x4*)(conv_w + 1024 + cc), cw3 = *(const GAS f32x4*)(conv_w + 1536 + cc), cb = *(const GAS f32x4*)(conv_b + cc);
            const int t0 = 32 * half + 8 * seg;
            const GAS bf16* base = proj + (size_t)((OFF_CX + cc) >> 8) * PTILE + (R0 + t0) * 256 + ((OFF_CX + cc) & 255);
            const bool pv = (t0 > 0) || (tt > 0);
            v2u rw[11];
#pragma unroll
            for (int r = 0; r < 11; ++r) { rw[r] = (v2u){0u, 0u}; if (r >= 3 || pv) rw[r] = *(const GAS v2u*)(base + (r - 3) * 256); }
            f32x4 x0 = {bflo(rw[0].x), bfhi(rw[0].x), bflo(rw[0].y), bfhi(rw[0].y)}, x1 = {bflo(rw[1].x), bfhi(rw[1].x), bflo(rw[1].y), bfhi(rw[1].y)}, x2 = {bflo(rw[2].x), bfhi(rw[2].x), bflo(rw[2].y), bfhi(rw[2].y)};
#pragma unroll
            for (int r = 0; r < 8; ++r) {
                const v2u w = rw[r + 3]; const f32x4 cur = {bflo(w.x), bfhi(w.x), bflo(w.y), bfhi(w.y)};
                const f32x4 cv = cb + cw0 * x0 + cw1 * x1 + cw2 * x2 + cw3 * cur; x0 = x1; x1 = x2; x2 = cur;
                v2u ov; ov.x = pk2(cv.x, cv.y); ov.y = pk2(cv.z, cv.w);
                *(LAS v2u*)(cimg + (8 * seg + r) * 144 + oc * 8) = ov;
            }
        }
        asm volatile("s_waitcnt lgkmcnt(0)" ::: "memory");
#pragma unroll 1
        for (int mm = 0; mm < 2; ++mm) {
            const int m = 2 * half + mm;
            bf16x8 XA[2];
#pragma unroll
            for (int kk = 0; kk < 2; ++kk) XA[kk] = *(const LAS bf16x8*)(cimg + (16 * mm + o) * 144 + (32 * kk + 8 * g) * 2);
#pragma unroll
            for (int n = 0; n < 4; ++n) {
                f32x4 Da = {0.f, 0.f, 0.f, 0.f}, Dx = {0.f, 0.f, 0.f, 0.f};
                Da = MFMA16(XA[0], WA[n][0], Da); Da = MFMA16(XA[1], WA[n][1], Da);
                Dx = MFMA16(XA[0], WX[n][0], Dx); Dx = MFMA16(XA[1], WX[n][1], Dx);
                float aa[4], bb[4];
#pragma unroll
                for (int hp = 0; hp < 2; ++hp) {
                    const f32x2 da = {Da[2 * hp], Da[2 * hp + 1]}, dx = {Dx[2 * hp], Dx[2 * hp + 1]};
                    f32x2 ta = da * (-1.4426950408889634f) + nba[n], tx = dx * (-1.4426950408889634f) + nbx[n];
                    ta = __builtin_elementwise_min(__builtin_elementwise_max(ta, (f32x2){-40.f, -40.f}), (f32x2){40.f, 40.f}); tx = __builtin_elementwise_min(__builtin_elementwise_max(tx, (f32x2){-40.f, -40.f}), (f32x2){40.f, 40.f});
                    f32x2 ea, ex; ea.x = __builtin_amdgcn_exp2f(ta.x); ea.y = __builtin_amdgcn_exp2f(ta.y); ex.x = __builtin_amdgcn_exp2f(tx.x); ex.y = __builtin_amdgcn_exp2f(tx.y);
                    const f32x2 qa = ea + 1.0f, qx = ex + 1.0f, qq = qa * qx;
                    f32x2 rc; rc.x = __builtin_amdgcn_rcpf(qq.x); rc.y = __builtin_amdgcn_rcpf(qq.y);
                    const f32x2 r = qx * rc, ig = qa * rc;
                    const f32x2 la = r * psp[n], al = r * pspl[n], x2v = la + la;
                    f32x2 av; av.x = __builtin_amdgcn_exp2f(al.x); av.y = __builtin_amdgcn_exp2f(al.y);
                    f32x2 ser = x2v * 0.0083333338f + 0.041666668f; ser = ser * x2v + 0.16666667f; ser = ser * x2v + 0.5f; ser = ser * x2v + 1.0f; ser = ser * (-x2v);
                    const f32x2 fm = 1.0f - av * av;
                    f32x2 em; em.x = (x2v.x > -0.25f) ? ser.x : fm.x; em.y = (x2v.y > -0.25f) ? ser.y : fm.y;
                    f32x2 sq; sq.x = __builtin_amdgcn_sqrtf(em.x); sq.y = __builtin_amdgcn_sqrtf(em.y);
                    f32x2 cv; cv.x = bf2f(*(const LAS bf16*)(cimg + (16 * mm + 4 * g + 2 * hp) * 144 + (16 * n + o) * 2)); cv.y = bf2f(*(const LAS bf16*)(cimg + (16 * mm + 4 * g + 2 * hp + 1) * 144 + (16 * n + o) * 2));
                    const f32x2 bv = sq * ig * cv;
                    aa[2 * hp] = av.x; aa[2 * hp + 1] = av.y; bb[2 * hp] = bv.x; bb[2 * hp + 1] = bv.y;
                }
                float Hr[4], Ar[4], Hrun = 0.f, Arun = 1.0f;
#pragma unroll
                for (int reg = 0; reg < 4; ++reg) { Hrun = aa[reg] * Hrun + bb[reg]; Arun *= aa[reg]; Hr[reg] = Hrun; Ar[reg] = Arun; }
                float Ht = Hrun, At = Arun;
                { const float Hp = __shfl_up(Ht, 16), Ap = __shfl_up(At, 16); if (g >= 1) { Ht = At * Hp + Ht; At = Ap * At; } }
                { const float Hp = __shfl_up(Ht, 32), Ap = __shfl_up(At, 32); if (g >= 2) { Ht = At * Hp + Ht; At = Ap * At; } }
                float He = __shfl_up(Ht, 16), Ae = __shfl_up(At, 16); if (g == 0) { He = 0.f; Ae = 1.0f; }
                const float Hpre = Ae * hc[n] + He, Ppre = Pc[n] * Ae;
                float hv = 0.f, pv = 1.f;
                const size_t so = (R0 + 16 * m + 4 * g) * 512 + 64 * h + 16 * n + o;
#pragma unroll
                for (int reg = 0; reg < 4; ++reg) { hv = Hr[reg] + Ar[reg] * Hpre; pv = Ar[reg] * Ppre;
                    const bf16 hq = f2bf(hv); const unsigned char pq = (unsigned char)(pv * 255.0f + 0.5f);
                    if (m < PARK_M0) { hloc[so + reg * 512] = hq; Pbuf[so + reg * 512] = pq; }
                    else { const int pr = 16 * (m - PARK_M0) + 4 * g + reg, pc = 64 * h + 16 * n + o; *(LAS bf16*)(lds + L_PARKH + pr * 1024 + pc * 2) = hq; *(LAS unsigned char*)(lds + L_PARKP + pr * 512 + pc) = pq; } }
                hc[n] = __shfl(hv, 48 + o); Pc[n] = __shfl(pv, 48 + o);
            }
        }
    }
    if (g == 0) {
#pragma unroll
        for (int n = 0; n < 4; ++n) { const int c = 64 * h + 16 * n + o;
            __hip_atomic_store(aggL + (size_t)T * 512 + c, Pc[n], __ATOMIC_RELAXED, __HIP_MEMORY_SCOPE_AGENT); __hip_atomic_store(aggH + (size_t)T * 512 + c, hc[n], __ATOMIC_RELAXED, __HIP_MEMORY_SCOPE_AGENT); } }
    asm volatile("s_waitcnt vmcnt(0)" ::: "memory");
}

__device__ __forceinline__ void finish_rows(LAS unsigned char* ytile, const GAS bf16* mulp, const GAS bf16* zp, GAS bf16* outp, int tid) {
    const int c8 = 8 * (tid & 31), tb = tid >> 5;
#pragma unroll 4
    for (int i = 0; i < 8; ++i) { const int t = tb + 16 * i;
        float y[8], z[8]; unpack8(*(const LAS v4u*)(ytile + t * 528 + c8 * 2), y); unpack8(*(const GAS v4u*)(zp + (size_t)t * 256 + c8), z);
        if (mulp) { float u[8]; unpack8(*(const GAS v4u*)(mulp + (size_t)t * 256 + c8), u);
#pragma unroll
            for (int e = 0; e < 8; ++e) y[e] *= u[e]; }
        float ss = 0.f;
#pragma unroll
        for (int e = 0; e < 8; ++e) ss += y[e] * y[e];
        ss += __shfl_xor(ss, 1); ss += __shfl_xor(ss, 2); ss += __shfl_xor(ss, 4); ss += __shfl_xor(ss, 8); ss += __shfl_xor(ss, 16);
        const float rstd = __builtin_amdgcn_rsqf(ss * (1.0f / 256.0f) + EPS);
#pragma unroll
        for (int e = 0; e < 8; ++e) y[e] = y[e] * rstd * silu(z[e]);
        *(GAS v4u*)(outp + (size_t)t * DM + c8) = pack8(y); }
}

__device__ __forceinline__ void mixer_a(LAS unsigned char* lds, const GAS bf16* proj, const GAS bf16* sguW, const GAS float* sgu_g, const GAS float* sgu_b, GAS bf16* ybuf, int T, int tid, int wid, int lane) {
    const int g = lane >> 4, o = lane & 15;
    const size_t R0 = (size_t)T * TILE;
    LAS float* rstdv = (LAS float*)(lds + L_RSTDV); LAS unsigned char* ytile = lds + L_YT;
    { const int jo = tid & 15, co = tid >> 4;
        LAS float* part = (LAS float*)(lds + L_RSTDV + 512);
        float sg[8]; { const f32x4 a = *(const GAS f32x4*)(sgu_g + 8 * co), b = *(const GAS f32x4*)(sgu_g + 8 * co + 4); sg[0] = a.x; sg[1] = a.y; sg[2] = a.z; sg[3] = a.w; sg[4] = b.x; sg[5] = b.y; sg[6] = b.z; sg[7] = b.w; }
        v4u rows[8]; float rs[8];
#pragma unroll
        for (int r = 0; r < 8; ++r) rows[r] = *(const GAS v4u*)(proj + (size_t)(OFF_AV >> 8) * PTILE + (R0 + 8 * jo + r) * 256 + 8 * co);
#pragma unroll
        for (int r = 0; r < 8; ++r) { float x[8]; unpack8(rows[r], x); float s = 0.f;
#pragma unroll
            for (int e = 0; e < 8; ++e) s += x[e] * x[e];
            s += __shfl_xor(s, 16); s += __shfl_xor(s, 32);
            if (lane < 16) part[wid * 128 + 8 * jo + r] = s; }
        __syncthreads();
        if (tid < 128) { float s = 0.f;
#pragma unroll
            for (int w = 0; w < 8; ++w) s += part[w * 128 + tid];
            rstdv[tid] = __builtin_amdgcn_rsqf(s * (1.0f / 256.0f) + EPS); }
        __syncthreads();
#pragma unroll
        for (int r = 0; r < 8; ++r) rs[r] = rstdv[8 * jo + r];
#pragma unroll
        for (int e = 0; e < 8; ++e) { float v[8];
#pragma unroll
            for (int r = 0; r < 8; ++r) { const unsigned w = rows[r][e >> 1]; v[r] = ((e & 1) ? bfhi(w) : bflo(w)) * rs[r] * sg[e]; }
            *(LAS v4u*)(lds + (8 * co + e) * 272 + 16 * jo) = pack8(v); }
    }
    __syncthreads();
    const int h = wid & 3, hf = wid >> 2;
    bf16x8 XW[4][4];
#pragma unroll
    for (int m = 0; m < 4; ++m)
#pragma unroll
        for (int kk = 0; kk < 4; ++kk) { XW[m][kk] = (bf16x8){0, 0, 0, 0, 0, 0, 0, 0}; if (kk < 2 || hf) XW[m][kk] = *(const GAS bf16x8*)(sguW + ((h * 128 + 64 * hf + 16 * m + o) * 128 + 8 * g) + 32 * kk); }
#pragma unroll
    for (int m = 0; m < 4; ++m) {
        f32x4 D[4];
#pragma unroll
        for (int n = 0; n < 4; ++n) D[n] = (f32x4){0.f, 0.f, 0.f, 0.f};
#pragma unroll
        for (int kk = 0; kk < 4; ++kk) if (kk < 2 || hf) {
#pragma unroll
            for (int n = 0; n < 4; ++n) { const bf16x8 Y = *(const LAS bf16x8*)(lds + (64 * h + 16 * n + o) * 272 + (32 * kk + 8 * g) * 2); D[n] = MFMA16(XW[m][kk], Y, D[n]); }
        }
        const int tb = 64 * hf + 16 * m + 4 * g;
        const f32x4 bias = *(const GAS f32x4*)(sgu_b + h * 128 + tb);
#pragma unroll
        for (int reg = 0; reg < 4; ++reg)
#pragma unroll
            for (int n = 0; n < 4; ++n) *(LAS bf16*)(ytile + (tb + reg) * 528 + (64 * h + 16 * n + o) * 2) = f2bf(D[n][reg] + bias[reg]);
    }
    __syncthreads();
    finish_rows(ytile, proj + (size_t)(OFF_AU >> 8) * PTILE + R0 * 256, proj + (size_t)(OFF_AZ >> 8) * PTILE + R0 * 256, ybuf + R0 * DM, tid);
}

__device__ __forceinline__ void mixer_b(LAS unsigned char* lds, const GAS bf16* proj, const GAS bf16* poolWT, const GAS float* pool_b, const GAS float* pool_s, GAS bf16* ybuf, int T, int tid, int wid, int lane) {
    const int g = lane >> 4, o = lane & 15, tt = T % TPS;
    const size_t R0 = (size_t)T * TILE;
    LAS unsigned char* ytile = lds + L_YT;
    {
        const int oc = tid & 31, seg = tid >> 5, grp = oc >> 3, win = 2 << grp, t0 = 8 * seg;
        const GAS bf16* base = proj + (size_t)(OFF_BX >> 8) * PTILE + R0 * 256 + 8 * oc;
        v4u R[23];
#pragma unroll
        for (int i = 0; i < 23; ++i) { const int t = t0 - 15 + i; R[i] = (v4u){0u, 0u, 0u, 0u}; if (i >= 16 - win && (t >= 0 || tt > 0)) R[i] = *(const GAS v4u*)(base + (long)t * 256); }
        float S[8];
#pragma unroll
        for (int e = 0; e < 8; ++e) S[e] = 0.f;
#pragma unroll
        for (int i = 0; i < 15; ++i) { float x[8]; unpack8(R[i], x);
#pragma unroll
            for (int e = 0; e < 8; ++e) S[e] += x[e]; }
        const int pos0 = tt * TILE + t0;
#pragma unroll
        for (int r = 0; r < 8; ++r) { float cur[8], pv[8], od[8]; unpack8(R[15 + r], cur);
            const int cnt = min(pos0 + r + 1, win); const float inv = 1.0f / (float)cnt;
#pragma unroll
            for (int e = 0; e < 8; ++e) { S[e] += cur[e]; pv[e] = S[e] * inv - cur[e]; }
            *(LAS v4u*)(lds + (t0 + r) * 528 + oc * 16) = pack8(pv);
            v4u ow = R[r];
            if (grp == 0) ow = R[14 + r]; else if (grp == 1) ow = R[12 + r]; else if (grp == 2) ow = R[8 + r];
            unpack8(ow, od);
#pragma unroll
            for (int e = 0; e < 8; ++e) S[e] -= od[e];
        }
    }
    __syncthreads();
    const int gg = wid & 3, hf = wid >> 2;
    bf16x8 Y[4][2]; float pb[4], ps[4];
#pragma unroll
    for (int n = 0; n < 4; ++n) { const int c = 64 * gg + 16 * n + o; pb[n] = pool_b[c]; ps[n] = pool_s[c];
#pragma unroll
        for (int kk = 0; kk < 2; ++kk) Y[n][kk] = *(const GAS bf16x8*)(poolWT + ((gg * 64 + 16 * n + o) * 64 + 32 * kk + 8 * g)); }
#pragma unroll 1
    for (int m = 0; m < 4; ++m) {
        f32x4 D[4];
#pragma unroll
        for (int n = 0; n < 4; ++n) D[n] = (f32x4){0.f, 0.f, 0.f, 0.f};
#pragma unroll
        for (int kk = 0; kk < 2; ++kk) { const bf16x8 X = *(const LAS bf16x8*)(lds + (64 * hf + 16 * m + o) * 528 + (64 * gg + 32 * kk + 8 * g) * 2);
#pragma unroll
            for (int n = 0; n < 4; ++n) D[n] = MFMA16(X, Y[n][kk], D[n]); }
        const int tb = 64 * hf + 16 * m + 4 * g;
#pragma unroll
        for (int reg = 0; reg < 4; ++reg)
#pragma unroll
            for (int n = 0; n < 4; ++n) *(LAS bf16*)(ytile + (tb + reg) * 528 + (64 * gg + 16 * n + o) * 2) = f2bf((D[n][reg] + pb[n]) * ps[n]);
    }
    __syncthreads();
    finish_rows(ytile, (const GAS bf16*)nullptr, proj + (size_t)(OFF_BZ >> 8) * PTILE + R0 * 256, ybuf + R0 * DM + 256, tid);
}

__device__ __forceinline__ void p3_tile(LAS unsigned char* lds, const GAS bf16* proj, const GAS bf16* hloc, const GAS unsigned char* Pbuf, const GAS float* aggL, const GAS float* aggH, const GAS unsigned* flags, GAS bf16* ybuf, int T, int tid, int wid, int lane) {
    const int tt = T % TPS; const size_t R0 = (size_t)T * TILE;
    LAS float* hin = (LAS float*)(lds + L_HIN);
    const int Tb = T - tt;
    if (tid < tt) { const GAS unsigned* fw = flags + 16 * (Tb + tid); unsigned sp = 0;
        while (__hip_atomic_load(fw, __ATOMIC_RELAXED, __HIP_MEMORY_SCOPE_AGENT) == 0u) { __builtin_amdgcn_s_sleep(2); if (++sp > (1u << 22)) break; } }
    __syncthreads();
    { float Lv[31], Hv[31], hcar = 0.f;
#pragma unroll
        for (int j = 0; j < 31; ++j) { Lv[j] = 0.f; Hv[j] = 0.f; if (j < tt) { Lv[j] = __hip_atomic_load(aggL + (size_t)(Tb + j) * 512 + tid, __ATOMIC_RELAXED, __HIP_MEMORY_SCOPE_AGENT); Hv[j] = __hip_atomic_load(aggH + (size_t)(Tb + j) * 512 + tid, __ATOMIC_RELAXED, __HIP_MEMORY_SCOPE_AGENT); } }
#pragma unroll
        for (int j = 0; j < 31; ++j) if (j < tt) hcar = Lv[j] * hcar + Hv[j];
        hin[tid] = hcar; }
    __syncthreads();
    float hi[8];
#pragma unroll
    for (int e = 0; e < 8; ++e) hi[e] = hin[8 * lane + e];
#pragma unroll 8
    for (int rr = 0; rr < 16; ++rr) { const int t = wid + 8 * rr; const size_t row = R0 + t;
        float hl[8], L[8], z[8], hv[8];
        v4u hw; v2u pw; if (t < 16 * PARK_M0) { hw = *(const GAS v4u*)(hloc + row * 512 + 8 * lane); pw = *(const GAS v2u*)(Pbuf + row * 512 + 8 * lane); } else { hw = *(const LAS v4u*)(lds + L_PARKH + (t - 16 * PARK_M0) * 1024 + 16 * lane); pw = *(const LAS v2u*)(lds + L_PARKP + (t - 16 * PARK_M0) * 512 + 8 * lane); }
        unpack8(hw, hl); {
#pragma unroll
            for (int e = 0; e < 8; ++e) L[e] = (float)(((e < 4 ? pw.x : pw.y) >> (8 * (e & 3))) & 0xffu) * (1.0f / 255.0f); } unpack8(*(const GAS v4u*)(proj + (size_t)((OFF_CZ >> 8) + (lane >> 5)) * PTILE + row * 256 + 8 * (lane & 31)), z);
        float ss = 0.f;
#pragma unroll
        for (int e = 0; e < 8; ++e) { hv[e] = hl[e] + L[e] * hi[e]; ss += hv[e] * hv[e]; }
        ss = wave_sum(ss); const float rstd = __builtin_amdgcn_rsqf(ss * (1.0f / 512.0f) + EPS);
#pragma unroll
        for (int e = 0; e < 8; ++e) hv[e] = hv[e] * rstd * silu(z[e]);
        *(GAS v4u*)(ybuf + row * DM + 512 + 8 * lane) = pack8(hv);
    }
    __syncthreads();
}

#define XB_TMO      128
#define XB_XCNT(j)  (256  + 64 * (j))
#define XB_XSUB(j)  (1280 + 64 * (j))
#define XB_XGEN(j)  (2304 + 64 * (j))
#define XB_TOP      3328
#define XB_TOPGEN   3392
#define XCD_BAR_WORDS 3456
#define XB_SPIN_CAP (1u << 18)

__device__ __forceinline__ unsigned xb_ld(unsigned* p)              { return __hip_atomic_load(p, __ATOMIC_RELAXED, __HIP_MEMORY_SCOPE_AGENT); }
__device__ __forceinline__ unsigned xb_add(unsigned* p, unsigned v) { return __hip_atomic_fetch_add(p, v, __ATOMIC_RELAXED, __HIP_MEMORY_SCOPE_AGENT); }
__device__ __forceinline__ unsigned xb_xcc_id() { return (unsigned)__builtin_amdgcn_s_getreg((3 << 11) | 20) & 0xFu; }
#define XB_SPIN(cond, bar) do { unsigned _sp = 0; while (cond) { __builtin_amdgcn_s_sleep(1); \
    if ((++_sp & 255u) == 0u) { if (xb_ld(&(bar)[XB_TMO])) break; if (_sp > XB_SPIN_CAP) { atomicAdd(&(bar)[XB_TMO], 1u); break; } } } } while (0)

struct XcdBarrier {
    unsigned* bar; unsigned x;
    volatile LAS unsigned* st;
};

__device__ __forceinline__ XcdBarrier xcd_barrier_post(unsigned* bar, volatile LAS unsigned* st) {
    XcdBarrier b; b.bar = bar; b.x = xb_xcc_id(); b.st = st;
    if (threadIdx.x == 0) (void)xb_add(&bar[XB_XCNT(b.x)], 1u);
    return b;
}
__device__ __forceinline__ void xcd_barrier_complete(unsigned* bar, unsigned x, unsigned& nloc, unsigned& nx) {
    const unsigned G = gridDim.x * gridDim.y * gridDim.z;
    unsigned sum, cnt, mine, sp = 0u;
    for (;;) {
        sum = 0u; cnt = 0u; mine = 0u;
#pragma unroll
        for (unsigned j = 0; j < 16; ++j) { const unsigned c = xb_ld(&bar[XB_XCNT(j)]); sum += c; cnt += (c > 0u) ? 1u : 0u; mine = (j == x) ? c : mine; }
        if (sum == G) break;
        __builtin_amdgcn_s_sleep(1);
        if ((++sp & 255u) == 0u) { if (xb_ld(&bar[XB_TMO])) break; if (sp > XB_SPIN_CAP) { atomicAdd(&bar[XB_TMO], 1u); break; } }
    }
    nloc = mine > 0u ? mine : 1u; nx = cnt > 0u ? cnt : 1u;
}

__device__ __forceinline__ void xcd_barrier(const XcdBarrier& b) {
    asm volatile("s_waitcnt vmcnt(0)" ::: "memory");
    __syncthreads();
    if (threadIdx.x == 0) {
        unsigned* bar = b.bar;
        __builtin_amdgcn_s_waitcnt(0);
        unsigned nloc = b.st[0], nx = b.st[1];
        if (nloc == 0u) { xcd_barrier_complete(bar, b.x, nloc, nx); b.st[0] = nloc; b.st[1] = nx; }
        const unsigned old = xb_add(&bar[XB_XSUB(b.x)], 1u);
        const unsigned gen = old / nloc;
        if (old + 1u == (gen + 1u) * nloc) {
            __builtin_amdgcn_fence(__ATOMIC_RELEASE, "agent");
            asm volatile("s_waitcnt vmcnt(0)" ::: "memory");
            const unsigned og = xb_add(&bar[XB_TOP], 1u);
            const unsigned tg = og / nx;
            if (og + 1u == (tg + 1u) * nx) xb_add(&bar[XB_TOPGEN], 1u);
            else XB_SPIN(xb_ld(&bar[XB_TOPGEN]) == tg, bar);
            __builtin_amdgcn_fence(__ATOMIC_ACQUIRE, "agent");
            xb_add(&bar[XB_XGEN(b.x)], 1u);
            asm volatile("s_waitcnt vmcnt(0)" ::: "memory");
        } else {
            XB_SPIN(xb_ld(&bar[XB_XGEN(b.x)]) == gen, bar);
            __builtin_amdgcn_fence(__ATOMIC_ACQUIRE, "agent");
            asm volatile("s_waitcnt vmcnt(0)" ::: "memory");
        }
    }
    __syncthreads();
}

#ifndef REP_P0
#define REP_P0 1
#endif
#ifndef REP_P1
#define REP_P1 1
#endif
#ifndef REP_P2
#define REP_P2 1
#endif
#ifndef REP_P3
#define REP_P3 1
#endif
#ifndef REP_C
#define REP_C 1
#endif
#ifndef REP_A
#define REP_A 1
#endif
#ifndef REP_B
#define REP_B 1
#endif
#ifndef REP_F
#define REP_F 1
#endif
typedef __attribute__((address_space(4))) const unsigned long long* kptr_t;
__device__ __forceinline__ unsigned long long karg(int i) { kptr_t k = (kptr_t)__builtin_amdgcn_kernarg_segment_ptr(); asm volatile("" : "+s"(k)); return k[i]; }
#define KIN(i) ((const GAS float*)karg(i))
#define KOUT ((GAS float*)karg(19))
#define KWS ((GAS unsigned char*)karg(20))

__global__ void __launch_bounds__(NTHR, 2) hybrid_fwd(Params p) {
    extern __shared__ __attribute__((aligned(16))) unsigned char lds_raw[];
    cg::grid_group grid = cg::this_grid();
    LAS unsigned char* lds = (LAS unsigned char*)lds_raw;
    if (threadIdx.x < 16) ((LAS unsigned*)(lds + L_MISC))[threadIdx.x] = 0u;
    __syncthreads();
    const XcdBarrier bar = xcd_barrier_post((unsigned*)(KWS + WS_CTL), (volatile LAS unsigned*)(lds + L_MISC));
    if (gridDim.x == 0x7fffffffu) grid.sync();
#define GRID_BAR() xcd_barrier(bar)
#ifdef TS_A
#define STAMP(k) do { if (threadIdx.x == 0) ((volatile LAS unsigned*)(lds + L_MISC))[2 + (k)] = (unsigned)__builtin_amdgcn_s_memrealtime(); } while (0)
#else
#define STAMP(k) do {} while (0)
#endif
    STAMP(0);
#ifndef NO_P0
    for (int rep0 = 0; rep0 < REP_P0; ++rep0)
    { int tid = threadIdx.x; asm volatile("" : "+v"(tid)); p0_prologue(p, lds, tid, tid & 63, __builtin_amdgcn_readfirstlane(tid >> 6)); }
#endif
    GRID_BAR();
    STAMP(1);
#pragma unroll 1
    for (int l = 0; l < 2; ++l) {
#ifndef NO_P1
        for (int rep1 = 0; rep1 < REP_P1; ++rep1)
        {
            GAS unsigned char* ws = KWS;
            pg8::Gemm g{(const bf16*)(ws + WS_H), (const bf16*)(ws + WS_WIN) + (size_t)l * DIN * DM, MROWS, DIN, DM};
            pg8::EpiProj E{(GAS bf16*)(ws + WS_PROJ), (const GAS float*)(ws + WS_ROWSS) + l * MROWS, DIN};
            if (l == 0 && gridDim.x == 256) {
                if (blockIdx.x >= 128) { int td = threadIdx.x; asm volatile("" : "+v"(td)); p0b_convert(KIN(0), ws, (int)blockIdx.x - 128, td & 63, __builtin_amdgcn_readfirstlane(td >> 6)); }
                else { int td = threadIdx.x; asm volatile("" : "+v"(td)); p0_deferred(KIN(2) + (size_t)DM * DIN, KIN(1) + DM, KIN(17), KIN(16), ws, lds, 0, 128, td & 63, __builtin_amdgcn_readfirstlane(td >> 6)); }
                __syncthreads();
                pg8::PanelOrder S{(int)blockIdx.x, (const unsigned*)(ws + WS_CTL + CTL_READY), 8u};
                pg8::gemm_phase<pg8::EpiProj, pg8::PanelOrder, true, true>(lds, g, S, E);
            } else { pg8::StaticOrder S; S.init(MROWS, DIN, gridDim.x, (int)blockIdx.x);
                pg8::gemm_phase<pg8::EpiProj, pg8::StaticOrder, true, true>(lds, g, S, E); }
        }
#endif
        GRID_BAR();
        if (l == 0) STAMP(2);
#ifndef NO_P2
        for (int rep2 = 0; rep2 < REP_P2; ++rep2)
        for (int T = blockIdx.x; T < NTILES; T += gridDim.x) {
            int tid = threadIdx.x; asm volatile("" : "+v"(tid)); const int lane = tid & 63, wave = __builtin_amdgcn_readfirstlane(tid >> 6);
            GAS unsigned char* ws = KWS; const GAS bf16* proj = (const GAS bf16*)(ws + WS_PROJ); GAS bf16* ybuf = (GAS bf16*)(ws + WS_Y);
            GAS bf16* hloc = (GAS bf16*)(ws + WS_SCAN); GAS float* aggL = (GAS float*)(ws + WS_AGG); GAS unsigned* flags = (GAS unsigned*)(ws + WS_CTL + CTL_FLAGS) + l * NTILES * 16;
            mixer_c(lds, proj, (const GAS bf16*)(ws + WS_WA) + l * 8 * 4096, (const GAS bf16*)(ws + WS_WX) + l * 8 * 4096, KIN(9) + l * 4 * 512, KIN(10) + l * 512,
                    KIN(12) + l * 512, KIN(14) + l * 512, KIN(15) + l * 512, hloc, (GAS unsigned char*)(hloc + (size_t)MROWS * 512), aggL, aggL + NTILES * 512, T, wave, lane);
            __syncthreads();
            if (l == 0) STAMP(3);
            if (tid == 0) __hip_atomic_store(flags + 16 * T, 1u, __ATOMIC_RELAXED, __HIP_MEMORY_SCOPE_AGENT);
            p3_tile(lds, proj, hloc, (const GAS unsigned char*)(hloc + (size_t)MROWS * 512), aggL, aggL + NTILES * 512, flags, ybuf, T, tid, wave, lane);
            mixer_a(lds, proj, (const GAS bf16*)(ws + WS_SGUW) + l * 4 * 128 * 128, KIN(3) + l * 256, KIN(5) + l * 512, ybuf, T, tid, wave, lane);
            mixer_b(lds, proj, (const GAS bf16*)(ws + WS_POOLW) + l * 4 * 4096, KIN(7) + l * 256, KIN(8) + l * 256, ybuf, T, tid, wave, lane);
            __syncthreads();
        }
#endif
#ifdef TS_A
        if (l == 1 && blockIdx.x == 0 && threadIdx.x == 0) { volatile LAS unsigned* st = (volatile LAS unsigned*)(lds + L_MISC) + 2; *(unsigned*)(KWS + WS_CTL + CTL_DBG) = st[TS_B] - st[TS_A]; }
#endif
        GRID_BAR();
        if (l == 0) STAMP(7);
#ifndef NO_P4
        {
            GAS unsigned char* ws = KWS; GAS float* out = KOUT;
            pg8::Gemm g{(const bf16*)(ws + WS_Y), (const bf16*)(ws + WS_WOUT) + (size_t)l * DM * DM, MROWS, DM, DM}; pg8::StaticOrder S; S.init(MROWS, DM, gridDim.x, (int)blockIdx.x);
            if (l == 0) { pg8::EpiOut E{(GAS bf16*)(ws + WS_H), (GAS float*)(ws + WS_ROWSS) + MROWS};
                pg8::gemm_phase<pg8::EpiOut, pg8::StaticOrder, true, true>(lds, g, S, E); }
            else { pg8::EpiOutFinal E{(const GAS bf16*)(ws + WS_H), out, (GAS float*)(ws + WS_ROWSS) + 2 * MROWS, (GAS unsigned*)(ws + WS_CTL + CTL_PANEL), KIN(18), (const GAS unsigned*)(ws + WS_CTL + CTL_DBG)};
                pg8::gemm_phase<pg8::EpiOutFinal, pg8::StaticOrder, true, true>(lds, g, S, E); }
        }
#endif
        if (l == 0) { GRID_BAR(); STAMP(8); }
    }
}

extern "C" void kernel_launch(void* const* d_in, const int* in_sizes, int n_in, void* d_out, int out_size, void* d_ws, size_t ws_size, hipStream_t stream) {
    static int grid = 0;
    if (grid == 0) {
        int dev = 0, cus = 0, per_cu = 0;
        if (n_in != 19 || out_size != MROWS * DM || ws_size < WS_END) { fprintf(stderr, "kernel_launch: unexpected shapes (n_in %d out %d ws %zu)\n", n_in, out_size, ws_size); grid = -1; return; }
        hipGetDevice(&dev); hipDeviceGetAttribute(&cus, hipDeviceAttributeMultiprocessorCount, dev);
        if (hipFuncSetAttribute((const void*)hybrid_fwd, hipFuncAttributeMaxDynamicSharedMemorySize, LDS_BYTES) != hipSuccess) { fprintf(stderr, "kernel_launch: hipFuncSetAttribute failed\n"); }
        if (hipOccupancyMaxActiveBlocksPerMultiprocessor(&per_cu, (const void*)hybrid_fwd, NTHR, LDS_BYTES) != hipSuccess || per_cu < 1) per_cu = 1;
        (void)hipGetLastError();
        if (per_cu > 1) per_cu = 1;
        grid = cus * per_cu;
        if (grid < 1) grid = 256;
        if (grid != 256) { fprintf(stderr, "kernel_launch: built for a 256-CU device (one workgroup per CU); got a grid of %d, nothing launched\n", grid); grid = -1; return; }
    }
    if (grid < 0) return;
    Params p{};
    for (int i = 0; i < 19; ++i) p.in[i] = (const float*)d_in[i];
    p.out = (float*)d_out; p.ws = (unsigned char*)d_ws;
    if (hipMemsetAsync((char*)d_ws + WS_CTL, 0, CTL_BYTES, stream) != hipSuccess) { fprintf(stderr, "kernel_launch: memset failed\n"); return; }
    void* args[] = {&p};
    hipError_t e = hipLaunchCooperativeKernel((const void*)hybrid_fwd, dim3(grid), dim3(NTHR), args, LDS_BYTES, stream);
    if (e != hipSuccess) fprintf(stderr, "kernel_launch: cooperative launch failed: %s (grid %d)\n", hipGetErrorString(e), grid);
}
```

```cpp
#include <hip/hip_runtime.h>
#include <hip/hip_cooperative_groups.h>
#include <cstdio>
#include <cstdint>
namespace cg = cooperative_groups;
namespace pg8 {
#define PG8_LAS __attribute__((address_space(3)))
typedef unsigned short bf16_t;
typedef short bf16x8 __attribute__((ext_vector_type(8)));
typedef float f32x4 __attribute__((ext_vector_type(4)));
typedef unsigned u32x4 __attribute__((ext_vector_type(4)));
constexpr int BM = 256, BK = 64, HALF = 128, HTB = HALF * BK * 2  , STAGE_BYTES = 8 * HTB, NXCD = 8, WGM = 8;

__host__ __device__ __forceinline__ int lds_byte(int r, int c) { const int st = (r >> 4) * 2 + (c >> 5), rr = r & 15, cc = c & 31, ob = rr * 64 + cc * 2; return st * 1024 + (ob ^ (((ob >> 9) & 1) << 5)); }
__host__ __device__ __forceinline__ void stage_rc(int b, int& R, int& C) { const int st = b / 1024, sb = b % 1024, swz = sb ^ (((sb >> 9) & 1) << 5); R = (st >> 1) * 16 + swz / 64; C = (st & 1) * 32 + (swz % 64) / 2; }
__host__ __device__ __forceinline__ int perm32(int rho) { const int n = rho >> 4, i = rho & 15; return 8 * (i >> 2) + 4 * n + (i & 3); }

struct Unit { int pm, pn; };
struct Gemm { const bf16_t* A; const bf16_t* Bt; int M, N, K; };

struct StaticOrder {
    int nM, nN, nwg, G, c;
    __host__ __device__ void init(int M, int N, int G_, int c_) { nM = M / BM; nN = N / BM; nwg = nM * nN; G = G_; c = c_; }
    __host__ __device__ bool next(int i, Unit& u) const {
        const long L = (long)i * G + c; if (L >= nwg) return false;
        int wgid = (int)L; { const int q = nwg / NXCD, r = nwg % NXCD, xcd = wgid % NXCD, off = wgid / NXCD; wgid = (xcd < r ? xcd * (q + 1) : r * (q + 1) + (xcd - r) * q) + off; }
        const int nig = WGM * nN, gid = wgid / nig, fm = gid * WGM, gsz = (nM - fm) < WGM ? (nM - fm) : WGM;
        u.pm = fm + ((wgid % nig) % gsz); u.pn = (wgid % nig) / gsz; return true;
    }
    __device__ __forceinline__ void a_ready(const Unit&) const {}
    __device__ __forceinline__ void done(const Unit&) const {}
};
struct PanelOrder {
    int c; const unsigned* ready; unsigned need;
    __device__ bool next(int i, Unit& u) const {
        const int late = c >> 7, cc = c & 127, slot = (cc & 7) * 16 + (cc >> 3);
        int base;
        if (!late) { if (i > 4) return false; base = (i == 0) ? 0 : (i == 1) ? 128 : (i == 2) ? 384 : (i == 3) ? 640 : 896; }
        else { if (i > 3) return false; base = 256 + 256 * i; }
        const int U = base + slot; u.pm = U / 9; u.pn = U - 9 * u.pm; return true;
    }
    __device__ __forceinline__ void a_ready(const Unit& u) const {
        if (threadIdx.x < 64) {
            unsigned sp = 0;
            while ((unsigned)__builtin_amdgcn_readfirstlane(__hip_atomic_load(ready + 64 * u.pm, __ATOMIC_RELAXED, __HIP_MEMORY_SCOPE_AGENT)) < need) { __builtin_amdgcn_s_sleep(2); if (++sp > (1u << 22)) break; }
            __builtin_amdgcn_fence(__ATOMIC_ACQUIRE, "agent");
            asm volatile("s_waitcnt vmcnt(0)" ::: "memory");
        }
        asm volatile("" ::: "memory"); __builtin_amdgcn_s_barrier(); asm volatile("" ::: "memory");
    }
    __device__ __forceinline__ void done(const Unit&) const {}
};

#if defined(__HIP_DEVICE_COMPILE__)
#define PG8_GAS __attribute__((address_space(1)))
#else
#define PG8_GAS
#endif
__device__ __forceinline__ unsigned cvt_pk_bf16(float lo, float hi) { unsigned r; asm volatile("v_cvt_pk_bf16_f32 %0, %1, %2" : "=v"(r) : "v"(lo), "v"(hi)); return r; }

struct EpiProj {
    static constexpr bool PERM = true, AFTER_DRAIN = false;
    PG8_GAS bf16_t* O; const PG8_GAS float* rowss; int ldc;
    __device__ __forceinline__ void operator()(const f32x4 (&acc)[2][2][4][2], const Unit& u, int wr, int wc, int fr, int fq) const {
        const int row0 = u.pm * BM + wr * 64 + fr, col0 = u.pn * BM + wc * 32 + 8 * fq;
#pragma unroll
        for (int ai = 0; ai < 2; ++ai)
#pragma unroll
            for (int m = 0; m < 4; ++m) {
                const int row = row0 + ai * HALF + m * 16;
                const float rs = __builtin_amdgcn_rsqf(rowss[row] * (1.0f / 1024.0f) + 1e-6f);
                PG8_GAS bf16_t* rowp = O + ((size_t)u.pn * 32768 + row) * 256 + (col0 - u.pn * BM);
#pragma unroll
                for (int bj = 0; bj < 2; ++bj) { const f32x4 v0 = acc[ai][bj][m][0] * rs, v1 = acc[ai][bj][m][1] * rs;
                    u32x4 w; w.x = cvt_pk_bf16(v0[0], v0[1]); w.y = cvt_pk_bf16(v0[2], v0[3]); w.z = cvt_pk_bf16(v1[0], v1[1]); w.w = cvt_pk_bf16(v1[2], v1[3]);
                    *(PG8_GAS u32x4*)(rowp + bj * HALF) = w; }
            }
    }
};
struct EpiOut {
    static constexpr bool PERM = true, AFTER_DRAIN = false;
    PG8_GAS bf16_t* hb; PG8_GAS float* rowss;
    __device__ __forceinline__ void operator()(const f32x4 (&acc)[2][2][4][2], const Unit& u, int wr, int wc, int fr, int fq) const {
        const int row0 = u.pm * BM + wr * 64 + fr, col0 = u.pn * BM + wc * 32 + 8 * fq;
#pragma unroll
        for (int ai = 0; ai < 2; ++ai) {
            u32x4 rw[4][2];
#pragma unroll
            for (int m = 0; m < 4; ++m)
#pragma unroll
                for (int bj = 0; bj < 2; ++bj) rw[m][bj] = *(const PG8_GAS u32x4*)(hb + (size_t)(row0 + ai * HALF + m * 16) * 1024 + col0 + bj * HALF);
#pragma unroll
            for (int m = 0; m < 4; ++m) {
                const int row = row0 + ai * HALF + m * 16;
                const size_t off = (size_t)row * 1024 + col0;
                float ss = 0.f;
#pragma unroll
                for (int bj = 0; bj < 2; ++bj) {
                    const u32x4 w0 = rw[m][bj];
                    const f32x4 r0 = {__uint_as_float(w0.x << 16), __uint_as_float(w0.x & 0xffff0000u), __uint_as_float(w0.y << 16), __uint_as_float(w0.y & 0xffff0000u)};
                    const f32x4 r1 = {__uint_as_float(w0.z << 16), __uint_as_float(w0.z & 0xffff0000u), __uint_as_float(w0.w << 16), __uint_as_float(w0.w & 0xffff0000u)};
                    const f32x4 v0 = acc[ai][bj][m][0] + r0, v1 = acc[ai][bj][m][1] + r1;
                    ss += (v0[0] * v0[0] + v0[1] * v0[1]) + (v0[2] * v0[2] + v0[3] * v0[3]) + (v1[0] * v1[0] + v1[1] * v1[1]) + (v1[2] * v1[2] + v1[3] * v1[3]);
                    u32x4 w; w.x = cvt_pk_bf16(v0[0], v0[1]); w.y = cvt_pk_bf16(v0[2], v0[3]); w.z = cvt_pk_bf16(v1[0], v1[1]); w.w = cvt_pk_bf16(v1[2], v1[3]);
                    *(PG8_GAS u32x4*)(hb + off + bj * HALF) = w;
                }
                ss += __shfl_xor(ss, 16); ss += __shfl_xor(ss, 32);
                if (fq == 0) __hip_atomic_fetch_add(rowss + row, ss, __ATOMIC_RELAXED, __HIP_MEMORY_SCOPE_AGENT);
            }
        }
    }
};
struct EpiOutFinal {
    static constexpr bool PERM = true, AFTER_DRAIN = false;
    const PG8_GAS bf16_t* resid; PG8_GAS float* out; PG8_GAS float* rowss; PG8_GAS unsigned* cnt; const PG8_GAS float* fg; const PG8_GAS unsigned* dbg;
    __device__ __forceinline__ void operator()(f32x4 (&acc)[2][2][4][2], const Unit& u, int wr, int wc, int fr, int fq) const {
        const int row0 = u.pm * BM + wr * 64 + fr, col0 = u.pn * BM + wc * 32 + 8 * fq;
#pragma unroll
        for (int am = 0; am < 4; ++am) { const int ai = am >> 1;
            f32x4 r[4][2][2];
#pragma unroll
            for (int m = 2 * (am & 1); m < 2 * (am & 1) + 2; ++m)
#pragma unroll
                for (int bj = 0; bj < 2; ++bj) { const size_t off = (size_t)(row0 + ai * HALF + m * 16) * 1024 + col0 + bj * HALF;
                    const u32x4 w = __builtin_nontemporal_load((const PG8_GAS u32x4*)(resid + off));
                    r[m][bj][0] = (f32x4){__uint_as_float(w.x << 16), __uint_as_float(w.x & 0xffff0000u), __uint_as_float(w.y << 16), __uint_as_float(w.y & 0xffff0000u)};
                    r[m][bj][1] = (f32x4){__uint_as_float(w.z << 16), __uint_as_float(w.z & 0xffff0000u), __uint_as_float(w.w << 16), __uint_as_float(w.w & 0xffff0000u)}; }
#pragma unroll
            for (int m = 2 * (am & 1); m < 2 * (am & 1) + 2; ++m) {
                const int row = row0 + ai * HALF + m * 16;
                float ss = 0.f;
#pragma unroll
                for (int bj = 0; bj < 2; ++bj) {
                    const f32x4 v0 = acc[ai][bj][m][0] + r[m][bj][0], v1 = acc[ai][bj][m][1] + r[m][bj][1];
                    acc[ai][bj][m][0] = v0; acc[ai][bj][m][1] = v1;
                    ss += (v0[0] * v0[0] + v0[1] * v0[1]) + (v0[2] * v0[2] + v0[3] * v0[3]) + (v1[0] * v1[0] + v1[1] * v1[1]) + (v1[2] * v1[2] + v1[3] * v1[3]);
                }
                ss += __shfl_xor(ss, 16); ss += __shfl_xor(ss, 32);
                if (fq == 0) __hip_atomic_fetch_add(rowss + row, ss, __ATOMIC_RELAXED, __HIP_MEMORY_SCOPE_AGENT);
            }
        }
        asm volatile("s_waitcnt vmcnt(0)" ::: "memory");
        PG8_GAS unsigned* c = cnt + 64 * u.pm;
        if ((threadIdx.x & 63) == 0) __hip_atomic_fetch_add(c, 1u, __ATOMIC_RELAXED, __HIP_MEMORY_SCOPE_AGENT);
        { unsigned sp = 0; while ((unsigned)__builtin_amdgcn_readfirstlane(__hip_atomic_load(c, __ATOMIC_RELAXED, __HIP_MEMORY_SCOPE_AGENT)) < 32u) { __builtin_amdgcn_s_sleep(2); if (++sp > (1u << 22)) break; } }
        asm volatile("" ::: "memory");
        f32x4 g0[2], g1[2];
#ifdef TS_A
        const float dlt = (float)dbg[0] * 1e-7f;
#else
        const float dlt = 0.f;
#endif
#pragma unroll
        for (int bj = 0; bj < 2; ++bj) { g0[bj] = *(const PG8_GAS f32x4*)(fg + col0 + bj * HALF); g1[bj] = *(const PG8_GAS f32x4*)(fg + col0 + bj * HALF + 4); }
#pragma unroll
        for (int ai = 0; ai < 2; ++ai)
#pragma unroll
            for (int m = 0; m < 4; ++m) {
                const int row = row0 + ai * HALF + m * 16;
                const float rs = __builtin_amdgcn_rsqf(__hip_atomic_load(rowss + row, __ATOMIC_RELAXED, __HIP_MEMORY_SCOPE_AGENT) * (1.0f / 1024.0f) + 1e-6f);
                PG8_GAS float* o = out + (size_t)row * 1024 + col0;
#pragma unroll
                for (int bj = 0; bj < 2; ++bj) { *(PG8_GAS f32x4*)(o + bj * HALF) = acc[ai][bj][m][0] * rs * g0[bj] + dlt; *(PG8_GAS f32x4*)(o + bj * HALF + 4) = acc[ai][bj][m][1] * rs * g1[bj] + dlt; }
            }
    }
};

template <class Epi, class Sched, bool ALIGN_EPI = false, bool SP2 = false>
__device__ __forceinline__ void gemm_phase(PG8_LAS unsigned char* lds, const Gemm g, const Sched& S, const Epi& E) {
    int tid_ = threadIdx.x; asm volatile("" : "+v"(tid_));
    const int tid = tid_, wid = __builtin_amdgcn_readfirstlane(tid >> 6), lane = tid & 63, wr = wid >> 2, wc = wid & 3, fr = lane & 15, fq = lane >> 4;
    const int K = g.K, nt = K / BK;
    unsigned voffA[2], voffB[2];
#pragma unroll
    for (int i = 0; i < 2; ++i) { int R, C; stage_rc(tid * 16 + i * 8192, R, C); const int Rb = Epi::PERM ? ((R & ~31) + perm32(R & 31)) : R;
        voffA[i] = (unsigned)(R * K + C) * 2u; voffB[i] = (unsigned)(Rb * K + C) * 2u; }
    const size_t kstep = (size_t)(BK * 2);
    const size_t hstep = (size_t)HALF * K * 2;
    const size_t tstep = 2 * hstep;
    const unsigned ldsw = (unsigned)wid * 1024u;
    const int aoff = lds_byte(wr * 64 + fr, fq * 8), boff = lds_byte(wc * 32 + fr, fq * 8);
#define PG8_SA(b, h) (((b) * 2 + (h)) * HTB)
#define PG8_SB(b, h) ((4 + (b) * 2 + (h)) * HTB)
#define PG8_STAGE(bufoff, gbase, voff) do { _Pragma("unroll") for (int _i = 0; _i < 2; ++_i) \
        __builtin_amdgcn_global_load_lds((const unsigned*)((const char*)(gbase) + (voff)[_i]), (PG8_LAS unsigned*)(lds + (bufoff) + ldsw + _i * 8192), 16, 0, 0); } while (0)
#define PG8_LDA(dst, b, h) do { _Pragma("unroll") for (int m = 0; m < 4; ++m) _Pragma("unroll") for (int k = 0; k < 2; ++k) dst[m][k] = *(const PG8_LAS bf16x8*)(lds + PG8_SA(b, h) + aoff + m * 2048 + k * 1024); } while (0)
#define PG8_LDB(dst, b, h) do { _Pragma("unroll") for (int n = 0; n < 2; ++n) _Pragma("unroll") for (int k = 0; k < 2; ++k) dst[n][k] = *(const PG8_LAS bf16x8*)(lds + PG8_SB(b, h) + boff + n * 2048 + k * 1024); } while (0)
#define PG8_MMA(ai, bj, At, Bt) do { __builtin_amdgcn_s_setprio(1); _Pragma("unroll") for (int m = 0; m < 4; ++m) _Pragma("unroll") for (int n = 0; n < 2; ++n) _Pragma("unroll") for (int k = 0; k < 2; ++k) \
        acc[ai][bj][m][n] = __builtin_amdgcn_mfma_f32_16x16x32_bf16(Bt[n][k], At[m][k], acc[ai][bj][m][n], 0, 0, 0); __builtin_amdgcn_s_setprio(0); } while (0)
#define PG8_WAIT_V(n) asm volatile("s_waitcnt vmcnt(" #n ")" ::: "memory")
#define PG8_WAIT_L(n) asm volatile("s_waitcnt lgkmcnt(" #n ")" ::: "memory")
#define PG8_BAR __builtin_amdgcn_s_barrier()
#define PG8_SCHED __builtin_amdgcn_sched_barrier(0)
    Unit cur, nxt; int ui = 0;
    if (!S.next(0, cur)) return;
    f32x4 acc[2][2][4][2];
#pragma unroll
    for (int a = 0; a < 2; ++a)
#pragma unroll
        for (int b = 0; b < 2; ++b)
#pragma unroll
            for (int m = 0; m < 4; ++m)
#pragma unroll
                for (int n = 0; n < 2; ++n) acc[a][b][m][n] = (f32x4){0.f, 0.f, 0.f, 0.f};
    bf16x8 At[4][2], B0[2][2], B1[2][2];
    const char* cA = (const char*)g.A + (size_t)cur.pm * tstep; const char* cB = (const char*)g.Bt + (size_t)cur.pn * tstep;
    S.a_ready(cur);
    if constexpr (SP2) {
        PG8_STAGE(PG8_SB(0, 0), cB, voffB); PG8_STAGE(PG8_SB(0, 1), cB + hstep, voffB); PG8_STAGE(PG8_SA(0, 0), cA, voffA); PG8_STAGE(PG8_SA(0, 1), cA + hstep, voffA);
        if (wr == 1) PG8_BAR;
        PG8_WAIT_V(2); PG8_BAR;
        PG8_STAGE(PG8_SB(1, 0), cB + kstep, voffB); PG8_STAGE(PG8_SA(1, 0), cA + kstep, voffA); PG8_STAGE(PG8_SB(1, 1), cB + hstep + kstep, voffB);
        PG8_WAIT_V(6); PG8_BAR;
    } else {
        PG8_STAGE(PG8_SB(0, 0), cB, voffB); PG8_STAGE(PG8_SA(0, 0), cA, voffA); PG8_STAGE(PG8_SB(0, 1), cB + hstep, voffB); PG8_STAGE(PG8_SA(0, 1), cA + hstep, voffA);
        if (wr == 1) PG8_BAR;
        PG8_WAIT_V(4); PG8_BAR;
        PG8_STAGE(PG8_SB(1, 0), cB + kstep, voffB); PG8_STAGE(PG8_SA(1, 0), cA + kstep, voffA); PG8_STAGE(PG8_SB(1, 1), cB + hstep + kstep, voffB);
        PG8_WAIT_V(6); PG8_BAR;
    }
    for (;;) {
        const bool has_next = S.next(ui + 1, nxt);
        const char* nA = has_next ? (const char*)g.A + (size_t)nxt.pm * tstep : cA; const char* nB = has_next ? (const char*)g.Bt + (size_t)nxt.pn * tstep : cB;
        for (int t = 0; t < nt; t += 2) {
            const bool last = (t == nt - 2);
            const char* a1 = cA + (size_t)(t + 1) * kstep;
            const char* a2 = last ? nA : cA + (size_t)(t + 2) * kstep; const char* b2 = last ? nB : cB + (size_t)(t + 2) * kstep;
            const char* a3 = a2 + kstep; const char* b3 = b2 + kstep;
            if (last && has_next) S.a_ready(nxt);
            if constexpr (SP2) {
            PG8_LDB(B0, 0, 0); PG8_LDB(B1, 0, 1); PG8_SCHED; PG8_LDA(At, 0, 0); PG8_STAGE(PG8_SA(1, 1), a1 + hstep, voffA);
            PG8_WAIT_V(8); PG8_WAIT_L(0); PG8_BAR; PG8_MMA(0, 0, At, B0); PG8_MMA(0, 1, At, B1); PG8_BAR; PG8_SCHED;
            PG8_LDA(At, 0, 1); PG8_STAGE(PG8_SB(0, 0), b2, voffB); PG8_STAGE(PG8_SB(0, 1), b2 + hstep, voffB); PG8_STAGE(PG8_SA(0, 0), a2, voffA);
            PG8_WAIT_V(8); PG8_WAIT_L(0); PG8_BAR; PG8_MMA(1, 0, At, B0); PG8_MMA(1, 1, At, B1); PG8_BAR; PG8_SCHED;
            PG8_LDB(B0, 1, 0); PG8_LDB(B1, 1, 1); PG8_SCHED; PG8_LDA(At, 1, 0); PG8_STAGE(PG8_SA(0, 1), a2 + hstep, voffA);
            PG8_WAIT_V(8); PG8_WAIT_L(0); PG8_BAR; PG8_MMA(0, 0, At, B0); PG8_MMA(0, 1, At, B1); PG8_BAR; PG8_SCHED;
            PG8_LDA(At, 1, 1); PG8_STAGE(PG8_SB(1, 0), b3, voffB); PG8_STAGE(PG8_SB(1, 1), b3 + hstep, voffB); PG8_STAGE(PG8_SA(1, 0), a3, voffA);
            PG8_WAIT_V(8); PG8_WAIT_L(0); PG8_BAR; PG8_MMA(1, 0, At, B0); PG8_MMA(1, 1, At, B1); PG8_BAR; PG8_SCHED;
            } else {
            PG8_LDB(B0, 0, 0); PG8_SCHED; PG8_LDA(At, 0, 0); PG8_STAGE(PG8_SA(1, 1), a1 + hstep, voffA);
            PG8_WAIT_L(8); PG8_BAR; PG8_WAIT_L(0); PG8_MMA(0, 0, At, B0); PG8_BAR; PG8_SCHED;
            PG8_LDB(B1, 0, 1); PG8_STAGE(PG8_SB(0, 0), b2, voffB);
            PG8_BAR; PG8_WAIT_L(0); PG8_MMA(0, 1, At, B1); PG8_BAR;
            PG8_LDA(At, 0, 1); PG8_STAGE(PG8_SA(0, 0), a2, voffA);
            PG8_BAR; PG8_WAIT_L(0); PG8_MMA(1, 0, At, B0); PG8_BAR; PG8_SCHED;
            PG8_STAGE(PG8_SB(0, 1), b2 + hstep, voffB);
            PG8_WAIT_V(6); PG8_BAR; PG8_MMA(1, 1, At, B1); PG8_BAR;
            PG8_LDB(B0, 1, 0); PG8_SCHED; PG8_LDA(At, 1, 0); PG8_STAGE(PG8_SA(0, 1), a2 + hstep, voffA);
            PG8_WAIT_L(8); PG8_BAR; PG8_WAIT_L(0); PG8_MMA(0, 0, At, B0); PG8_BAR; PG8_SCHED;
            PG8_LDB(B1, 1, 1); PG8_STAGE(PG8_SB(1, 0), b3, voffB);
            PG8_BAR; PG8_WAIT_L(0); PG8_MMA(0, 1, At, B1); PG8_BAR;
            PG8_LDA(At, 1, 1); PG8_STAGE(PG8_SA(1, 0), a3, voffA);
            PG8_BAR; PG8_WAIT_L(0); PG8_MMA(1, 0, At, B0); PG8_BAR; PG8_SCHED;
            PG8_STAGE(PG8_SB(1, 1), b3 + hstep, voffB);
            PG8_WAIT_V(6); PG8_BAR; PG8_MMA(1, 1, At, B1); PG8_BAR;
            }
        }
        if constexpr (ALIGN_EPI) { if (wr == 0) PG8_BAR; }
        if constexpr (!Epi::AFTER_DRAIN) { E(acc, cur, wr, wc, fr, fq); S.done(cur); }
        if (!has_next) break;
#pragma unroll
        for (int a = 0; a < 2; ++a)
#pragma unroll
            for (int b = 0; b < 2; ++b)
#pragma unroll
                for (int m = 0; m < 4; ++m)
#pragma unroll
                    for (int n = 0; n < 2; ++n) acc[a][b][m][n] = (f32x4){0.f, 0.f, 0.f, 0.f};
        cur = nxt; cA = nA; cB = nB; ++ui;
        if constexpr (ALIGN_EPI) { if (wr == 1) PG8_BAR; }
    }
    PG8_WAIT_V(0);
    if constexpr (!ALIGN_EPI) { if (wr == 0) PG8_BAR; }
    PG8_BAR;
    if constexpr (Epi::AFTER_DRAIN) { E.fused(acc, cur, wr, wc, fr, fq, lds, wid, lane); S.done(cur); }
#undef PG8_SA
#undef PG8_SB
#undef PG8_STAGE
#undef PG8_LDA
#undef PG8_LDB
#undef PG8_MMA
#undef PG8_WAIT_V
#undef PG8_WAIT_L
#undef PG8_BAR
#undef PG8_SCHED
}
}

constexpr int NWAVES = 8, NTHR = 512;
constexpr int MROWS = 32768, DM = 1024, DIN = 2304, SEQ = 4096, TILE = 128, NTILES = MROWS / TILE, TPS = SEQ / TILE;
constexpr size_t PTILE = (size_t)MROWS * 256;
constexpr int OFF_AU = 0, OFF_AV = 256, OFF_AZ = 512, OFF_BX = 768, OFF_BZ = 1024, OFF_CX = 1280, OFF_CZ = 1792;
constexpr float EPS = 1e-6f;
constexpr size_t MiB = 1u << 20;
constexpr size_t WS_WIN = 0;
constexpr size_t WS_WOUT = 9 * MiB;
constexpr size_t WS_SGUW = 13 * MiB;
constexpr size_t WS_POOLW = 13 * MiB + 256 * 1024;
constexpr size_t WS_WA = 13 * MiB + 512 * 1024;
constexpr size_t WS_WX = 13 * MiB + 768 * 1024;
constexpr size_t WS_ROWSS = 14 * MiB;
constexpr size_t WS_CTL = 14 * MiB + 512 * 1024, CTL_PANEL = 16384, CTL_FLAGS = 16384 + 32768, CTL_DBG = 16384 + 32768 + 32768, CTL_READY = 16384 + 32768 + 32768 + 256, CTL_BYTES = 16384 + 32768 + 32768 + 256 + 32768;
constexpr size_t WS_AGG = 15 * MiB;
constexpr size_t WS_H = 16 * MiB;
constexpr size_t WS_PROJ = 80 * MiB;
constexpr size_t WS_Y = 224 * MiB;
constexpr size_t WS_SCAN = 288 * MiB;
constexpr size_t WS_END = 352 * MiB;
constexpr int LDS_BYTES = 163840;

#define LAS __attribute__((address_space(3)))
#if defined(__HIP_DEVICE_COMPILE__)
#define GAS __attribute__((address_space(1)))
#else
#define GAS
#endif
typedef unsigned short bf16;
typedef unsigned v4u __attribute__((ext_vector_type(4)));
typedef unsigned v2u __attribute__((ext_vector_type(2)));
typedef float f32x4 __attribute__((ext_vector_type(4)));
typedef short bf16x8 __attribute__((ext_vector_type(8)));
typedef float f32x2 __attribute__((ext_vector_type(2)));

__device__ __forceinline__ unsigned pk2(float lo, float hi) { return pg8::cvt_pk_bf16(lo, hi); }
__device__ __forceinline__ float bflo(unsigned w) { return __uint_as_float(w << 16); }
__device__ __forceinline__ float bfhi(unsigned w) { return __uint_as_float(w & 0xffff0000u); }
__device__ __forceinline__ float bf2f(bf16 b) { return __uint_as_float(((unsigned)b) << 16); }
__device__ __forceinline__ bf16 f2bf(float f) { return (bf16)(pk2(f, 0.f) & 0xffffu); }
__device__ __forceinline__ float fexp(float x) { return __builtin_amdgcn_exp2f(x * 1.4426950408889634f); }
__device__ __forceinline__ float sigm(float x) { return __builtin_amdgcn_rcpf(1.0f + fexp(-x)); }
__device__ __forceinline__ float silu(float x) { return x * sigm(x); }
__device__ __forceinline__ float wave_sum(float v) {
#pragma unroll
    for (int o = 1; o < 64; o <<= 1) v += __shfl_xor(v, o);
    return v;
}
__device__ __forceinline__ void unpack8(const v4u w, float (&x)[8]) {
    x[0] = bflo(w.x); x[1] = bfhi(w.x); x[2] = bflo(w.y); x[3] = bfhi(w.y); x[4] = bflo(w.z); x[5] = bfhi(w.z); x[6] = bflo(w.w); x[7] = bfhi(w.w);
}
__device__ __forceinline__ v4u pack8(const float (&x)[8]) { v4u w; w.x = pk2(x[0], x[1]); w.y = pk2(x[2], x[3]); w.z = pk2(x[4], x[5]); w.w = pk2(x[6], x[7]); return w; }
#define MFMA16(a, b, c) __builtin_amdgcn_mfma_f32_16x16x32_bf16((a), (b), (c), 0, 0, 0)

struct Params {
    const float* in[19];
    float* out; unsigned char* ws;
};

__device__ __forceinline__ void p0_transpose_item(const GAS float* W, const GAS float* gk, int K, int N, GAS bf16* WT, LAS float* scr, int item, int lane) {
    const int nblk = N / 32, kb = item / nblk, nb = item % nblk, k0 = 64 * kb, n0 = 32 * nb;
    float wv[32];
#pragma unroll
    for (int i = 0; i < 32; ++i) { const int kk = 2 * i + (lane >> 5); wv[i] = W[(size_t)(k0 + kk) * N + n0 + (lane & 31)]; }
    const float g0 = gk[k0 + (lane & 31) + 0], g1 = gk[k0 + (lane & 31) + 32];
#pragma unroll
    for (int i = 0; i < 32; ++i) { const int kk = 2 * i + (lane >> 5); const float gsel = __shfl((2 * i < 32) ? g0 : g1, (lane & 32) + ((2 * i + (lane >> 5)) & 31)); scr[kk * 33 + (lane & 31)] = wv[i] * gsel; }
    asm volatile("s_waitcnt lgkmcnt(0)" ::: "memory");
    const int c = lane & 7;
#pragma unroll
    for (int j = 0; j < 4; ++j) { const int n = (lane >> 3) + 8 * j; const LAS float* s = scr + (8 * c) * 33 + n;
        v4u o; o.x = pk2(s[0 * 33], s[1 * 33]); o.y = pk2(s[2 * 33], s[3 * 33]); o.z = pk2(s[4 * 33], s[5 * 33]); o.w = pk2(s[6 * 33], s[7 * 33]);
        *(GAS v4u*)(WT + (size_t)(n0 + n) * K + k0 + 8 * c) = o; }
    asm volatile("s_waitcnt lgkmcnt(0)" ::: "memory");
}
__device__ __forceinline__ void p0_prologue(const Params& p, LAS unsigned char* lds, int tid, int lane, int wave) {
    unsigned char* ws = p.ws;
    LAS float* scr = (LAS float*)(lds + wave * 16384);
    const int G = gridDim.x, gw = blockIdx.x * NWAVES + wave, NGW = G * NWAVES;
    constexpr int I_IN = (DM / 64) * (DIN / 32), I_OUT = (DM / 64) * (DM / 32);
    for (int it = gw; it < I_IN; it += NGW)
        p0_transpose_item((const GAS float*)p.in[2], (const GAS float*)p.in[1], DM, DIN, (GAS bf16*)(ws + WS_WIN), scr, it, lane);
    const int gt = blockIdx.x * NTHR + tid, NGT = G * NTHR;
    for (int i = gt; i < 2 * 4 * 128 * 128; i += NGT) { const int jj = i & 127, ii = (i >> 7) & 127; const float m = ((jj >> 6) <= (ii >> 6)) ? 1.f : 0.f; ((GAS bf16*)(ws + WS_SGUW))[i] = f2bf(p.in[4][i] * m); }
    for (int i = gt; i < 2 * 4 * 64 * 64; i += NGT) { const int ii = i & 63, o = (i >> 6) & 63, lg = i >> 12; ((GAS bf16*)(ws + WS_POOLW))[i] = f2bf(p.in[6][(lg * 64 + ii) * 64 + o]); }
    for (int i = gt; i < 2 * 8 * 64 * 64; i += NGT) { const int ii = i & 63, o = (i >> 6) & 63, lh = i >> 12;
        ((GAS bf16*)(ws + WS_WA))[i] = f2bf(p.in[11][(lh * 64 + ii) * 64 + o]); ((GAS bf16*)(ws + WS_WX))[i] = f2bf(p.in[13][(lh * 64 + ii) * 64 + o]); }
    GAS float* rowss = (GAS float*)(ws + WS_ROWSS);
    for (int i = gt; i < 2 * MROWS; i += NGT) rowss[MROWS + i] = 0.f;
    {   const GAS float* x = (const GAS float*)p.in[0]; GAS bf16* hb = (GAS bf16*)(ws + WS_H);
        for (int m = gw; m < 4096; m += NGW) { const f32x4* xr = (const GAS f32x4*)(x + (size_t)m * DM) + lane; f32x4 v[4]; float s = 0.f;
#pragma unroll
            for (int j = 0; j < 4; ++j) v[j] = __builtin_nontemporal_load(xr + 64 * j);
            GAS unsigned long long* o8 = (GAS unsigned long long*)(hb + (size_t)m * DM) + lane;
#pragma unroll
            for (int j = 0; j < 4; ++j) { const f32x4 w = v[j]; s += (w.x * w.x + w.y * w.y) + (w.z * w.z + w.w * w.w); o8[64 * j] = (unsigned long long)pk2(w.x, w.y) | ((unsigned long long)pk2(w.z, w.w) << 32); }
            s = wave_sum(s);
            if (lane == 0) rowss[m] = s; }
        if (blockIdx.x == 0 && tid < 16) __hip_atomic_store((GAS unsigned*)(ws + WS_CTL + CTL_READY) + 64 * tid, 8u, __ATOMIC_RELAXED, __HIP_MEMORY_SCOPE_AGENT);
    }
}
__device__ __forceinline__ void p0b_convert(const GAS float* x, GAS unsigned char* ws, int lb, int lane, int wave) {
    GAS bf16* hb = (GAS bf16*)(ws + WS_H); GAS float* rowss = (GAS float*)(ws + WS_ROWSS); GAS unsigned* ready = (GAS unsigned*)(ws + WS_CTL + CTL_READY);
    const int q = lb >> 3, mem = lb & 7;
#pragma unroll 1
    for (int k = 1; k < 8; ++k) {
        const int pnl = 16 * k + q; const size_t r0 = (size_t)pnl * 256 + 32 * mem + 4 * wave;
        f32x4 v[4][4];
#pragma unroll
        for (int qq = 0; qq < 4; ++qq) { const f32x4* xr = (const GAS f32x4*)(x + (r0 + qq) * DM) + lane;
#pragma unroll
            for (int j = 0; j < 4; ++j) v[qq][j] = __builtin_nontemporal_load(xr + 64 * j); }
#pragma unroll
        for (int qq = 0; qq < 4; ++qq) { float s = 0.f; GAS unsigned long long* o8 = (GAS unsigned long long*)(hb + (r0 + qq) * DM) + lane;
#pragma unroll
            for (int j = 0; j < 4; ++j) { const f32x4 w = v[qq][j]; s += (w.x * w.x + w.y * w.y) + (w.z * w.z + w.w * w.w);
                __hip_atomic_store(o8 + 64 * j, (unsigned long long)pk2(w.x, w.y) | ((unsigned long long)pk2(w.z, w.w) << 32), __ATOMIC_RELAXED, __HIP_MEMORY_SCOPE_AGENT); }
            s = wave_sum(s);
            if (lane == 0) __hip_atomic_store(rowss + r0 + qq, s, __ATOMIC_RELAXED, __HIP_MEMORY_SCOPE_AGENT); }
        asm volatile("s_waitcnt vmcnt(0)" ::: "memory");
        __syncthreads();
        if (threadIdx.x == 0) __hip_atomic_fetch_add(ready + 64 * pnl, 1u, __ATOMIC_RELAXED, __HIP_MEMORY_SCOPE_AGENT);
    }
}

__device__ __forceinline__ void p0_deferred(const GAS float* w_in1, const GAS float* g1, const GAS float* w_out, const GAS float* bg, GAS unsigned char* ws, LAS unsigned char* lds, int first, int nb, int lane, int wave) {
    LAS float* scr = (LAS float*)(lds + wave * 16384);
    const int gw = ((int)blockIdx.x - first) * NWAVES + wave, NGW = nb * NWAVES;
    constexpr int I_IN = (DM / 64) * (DIN / 32), I_OUT = (DM / 64) * (DM / 32);
    for (int it = gw; it < I_IN + 2 * I_OUT; it += NGW) {
        int r = it;
        if (r < I_IN) { p0_transpose_item(w_in1, g1, DM, DIN, (GAS bf16*)(ws + WS_WIN) + (size_t)DIN * DM, scr, r, lane); continue; }
        r -= I_IN; { const int l = r / I_OUT; r -= l * I_OUT;
            p0_transpose_item(w_out + (size_t)l * DM * DM, bg + l * DM, DM, DM, (GAS bf16*)(ws + WS_WOUT) + (size_t)l * DM * DM, scr, r, lane); }
    }
}

static_assert(36864 + 16 * (8 - 3) * 1536 <= 163840 - 64, "parked scan rows fit in LDS");
constexpr int PARK_M0 = 3, PARK_ROWS = 16 * (8 - PARK_M0), L_PARKH = 36864, L_PARKP = L_PARKH + PARK_ROWS * 1024, L_YT = 73728, L_RSTDV = L_YT + 67584, L_HIN = 0, L_MISC = LDS_BYTES - 64;

__device__ __forceinline__ void mixer_c(LAS unsigned char* lds, const GAS bf16* proj, const GAS bf16* waT, const GAS bf16* wxT, const GAS float* conv_w, const GAS float* conv_b,
                                        const GAS float* lba, const GAS float* lbx, const GAS float* lam, GAS bf16* hloc, GAS unsigned char* Pbuf, GAS float* aggL, GAS float* aggH, int T, int wid, int lane) {
    const int h = wid, g = lane >> 4, o = lane & 15, tt = T % TPS;
    const size_t R0 = (size_t)T * TILE;
    LAS unsigned char* cimg = lds + wid * 4608;
    bf16x8 WA[4][2], WX[4][2];
#pragma unroll
    for (int n = 0; n < 4; ++n)
#pragma unroll
        for (int kk = 0; kk < 2; ++kk) { const int idx = (h * 64 + 16 * n + o) * 64 + 32 * kk + 8 * g; WA[n][kk] = *(const GAS bf16x8*)(waT + idx); WX[n][kk] = *(const GAS bf16x8*)(wxT + idx); }
    float nba[4], nbx[4], psp[4], pspl[4], hc[4], Pc[4];
#pragma unroll
    for (int n = 0; n < 4; ++n) { const int c = 64 * h + 16 * n + o; nba[n] = -1.4426950408889634f * lba[c]; nbx[n] = -1.4426950408889634f * lbx[c];
        const float xm = -lam[c]; psp[n] = -8.0f * (fmaxf(xm, 0.f) + log1pf(expf(-fabsf(xm)))); pspl[n] = psp[n] * 1.4426950408889634f; hc[n] = 0.f; Pc[n] = 1.0f; }
#pragma unroll 1
    for (int half = 0; half < 4; ++half) {
        {
            const int oc = lane & 15, seg = lane >> 4, cc = 64 * h + 4 * oc;
            f32x4 cw0 = *(const GAS f32x4*)(conv_w + cc), cw1 = *(const GAS f32x4*)(conv_w + 512 + cc), cw2 = *(const GAS f32x4*)(conv_w + 1024 + cc), cw3 = *(const GAS f32x4*)(conv_w + 1536 + cc), cb = *(const GAS f32x4*)(conv_b + cc);
            const int t0 = 32 * half + 8 * seg;
            const GAS bf16* base = proj + (size_t)((OFF_CX + cc) >> 8) * PTILE + (R0 + t0) * 256 + ((OFF_CX + cc) & 255);
            const bool pv = (t0 > 0) || (tt > 0);
            v2u rw[11];
#pragma unroll
            for (int r = 0; r < 11; ++r) { rw[r] = (v2u){0u, 0u}; if (r >= 3 || pv) rw[r] = *(const GAS v2u*)(base + (r - 3) * 256); }
            f32x4 x0 = {bflo(rw[0].x), bfhi(rw[0].x), bflo(rw[0].y), bfhi(rw[0].y)}, x1 = {bflo(rw[1].x), bfhi(rw[1].x), bflo(rw[1].y), bfhi(rw[1].y)}, x2 = {bflo(rw[2].x), bfhi(rw[2].x), bflo(rw[2].y), bfhi(rw[2].y)};
#pragma unroll
            for (int r = 0; r < 8; ++r) {
                const v2u w = rw[r + 3]; const f32x4 cur = {bflo(w.x), bfhi(w.x), bflo(w.y), bfhi(w.y)};
                const f32x4 cv = cb + cw0 * x0 + cw1 * x1 + cw2 * x2 + cw3 * cur; x0 = x1; x1 = x2; x2 = cur;
                v2u ov; ov.x = pk2(cv.x, cv.y); ov.y = pk2(cv.z, cv.w);
                *(LAS v2u*)(cimg + (8 * seg + r) * 144 + oc * 8) = ov;
            }
        }
        asm volatile("s_waitcnt lgkmcnt(0)" ::: "memory");
#pragma unroll 1
        for (int mm = 0; mm < 2; ++mm) {
            const int m = 2 * half + mm;
            bf16x8 XA[2];
#pragma unroll
            for (int kk = 0; kk < 2; ++kk) XA[kk] = *(const LAS bf16x8*)(cimg + (16 * mm + o) * 144 + (32 * kk + 8 * g) * 2);
#pragma unroll
            for (int n = 0; n < 4; ++n) {
                f32x4 Da = {0.f, 0.f, 0.f, 0.f}, Dx = {0.f, 0.f, 0.f, 0.f};
                Da = MFMA16(XA[0], WA[n][0], Da); Da = MFMA16(XA[1], WA[n][1], Da);
                Dx = MFMA16(XA[0], WX[n][0], Dx); Dx = MFMA16(XA[1], WX[n][1], Dx);
                float aa[4], bb[4];
#pragma unroll
                for (int hp = 0; hp < 2; ++hp) {
                    const f32x2 da = {Da[2 * hp], Da[2 * hp + 1]}, dx = {Dx[2 * hp], Dx[2 * hp + 1]};
                    f32x2 ta = da * (-1.4426950408889634f) + nba[n], tx = dx * (-1.4426950408889634f) + nbx[n];
                    ta = __builtin_elementwise_min(__builtin_elementwise_max(ta, (f32x2){-40.f, -40.f}), (f32x2){40.f, 40.f}); tx = __builtin_elementwise_min(__builtin_elementwise_max(tx, (f32x2){-40.f, -40.f}), (f32x2){40.f, 40.f});
                    f32x2 ea, ex; ea.x = __builtin_amdgcn_exp2f(ta.x); ea.y = __builtin_amdgcn_exp2f(ta.y); ex.x = __builtin_amdgcn_exp2f(tx.x); ex.y = __builtin_amdgcn_exp2f(tx.y);
                    const f32x2 qa = ea + 1.0f, qx = ex + 1.0f, qq = qa * qx;
                    f32x2 rc; rc.x = __builtin_amdgcn_rcpf(qq.x); rc.y = __builtin_amdgcn_rcpf(qq.y);
                    const f32x2 r = qx * rc, ig = qa * rc;
                    const f32x2 la = r * psp[n], al = r * pspl[n], x2v = la + la;
                    f32x2 av; av.x = __builtin_amdgcn_exp2f(al.x); av.y = __builtin_amdgcn_exp2f(al.y);
                    f32x2 ser = x2v * 0.0083333338f + 0.041666668f; ser = ser * x2v + 0.16666667f; ser = ser * x2v + 0.5f; ser = ser * x2v + 1.0f; ser = ser * (-x2v);
                    const f32x2 fm = 1.0f - av * av;
                    f32x2 em; em.x = (x2v.x > -0.25f) ? ser.x : fm.x; em.y = (x2v.y > -0.25f) ? ser.y : fm.y;
                    f32x2 sq; sq.x = __builtin_amdgcn_sqrtf(em.x); sq.y = __builtin_amdgcn_sqrtf(em.y);
                    f32x2 cv; cv.x = bf2f(*(const LAS bf16*)(cimg + (16 * mm + 4 * g + 2 * hp) * 144 + (16 * n + o) * 2)); cv.y = bf2f(*(const LAS bf16*)(cimg + (16 * mm + 4 * g + 2 * hp + 1) * 144 + (16 * n + o) * 2));
                    const f32x2 bv = sq * ig * cv;
                    aa[2 * hp] = av.x; aa[2 * hp + 1] = av.y; bb[2 * hp] = bv.x; bb[2 * hp + 1] = bv.y;
                }
                float Hr[4], Ar[4], Hrun = 0.f, Arun = 1.0f;
#pragma unroll
                for (int reg = 0; reg < 4; ++reg) { Hrun = aa[reg] * Hrun + bb[reg]; Arun *= aa[reg]; Hr[reg] = Hrun; Ar[reg] = Arun; }
                float Ht = Hrun, At = Arun;
                { const float Hp = __shfl_up(Ht, 16), Ap = __shfl_up(At, 16); if (g >= 1) { Ht = At * Hp + Ht; At = Ap * At; } }
                { const float Hp = __shfl_up(Ht, 32), Ap = __shfl_up(At, 32); if (g >= 2) { Ht = At * Hp + Ht; At = Ap * At; } }
                float He = __shfl_up(Ht, 16), Ae = __shfl_up(At, 16); if (g == 0) { He = 0.f; Ae = 1.0f; }
                const float Hpre = Ae * hc[n] + He, Ppre = Pc[n] * Ae;
                float hv = 0.f, pv = 1.f;
                const size_t so = (R0 + 16 * m + 4 * g) * 512 + 64 * h + 16 * n + o;
#pragma unroll
                for (int reg = 0; reg < 4; ++reg) { hv = Hr[reg] + Ar[reg] * Hpre; pv = Ar[reg] * Ppre;
                    const bf16 hq = f2bf(hv); const unsigned char pq = (unsigned char)(pv * 255.0f + 0.5f);
                    if (m < PARK_M0) { hloc[so + reg * 512] = hq; Pbuf[so + reg * 512] = pq; }
                    else { const int pr = 16 * (m - PARK_M0) + 4 * g + reg, pc = 64 * h + 16 * n + o; *(LAS bf16*)(lds + L_PARKH + pr * 1024 + pc * 2) = hq; *(LAS unsigned char*)(lds + L_PARKP + pr * 512 + pc) = pq; } }
                hc[n] = __shfl(hv, 48 + o); Pc[n] = __shfl(pv, 48 + o);
            }
        }
    }
    if (g == 0) {
#pragma unroll
        for (int n = 0; n < 4; ++n) { const int c = 64 * h + 16 * n + o;
            __hip_atomic_store(aggL + (size_t)T * 512 + c, Pc[n], __ATOMIC_RELAXED, __HIP_MEMORY_SCOPE_AGENT); __hip_atomic_store(aggH + (size_t)T * 512 + c, hc[n], __ATOMIC_RELAXED, __HIP_MEMORY_SCOPE_AGENT); } }
    asm volatile("s_waitcnt vmcnt(0)" ::: "memory");
}

__device__ __forceinline__ void finish_rows(LAS unsigned char* ytile, const GAS bf16* mulp, const GAS bf16* zp, GAS bf16* outp, int tid) {
    const int c8 = 8 * (tid & 31), tb = tid >> 5;
#pragma unroll 4
    for (int i = 0; i < 8; ++i) { const int t = tb + 16 * i;
        float y[8], z[8]; unpack8(*(const LAS v4u*)(ytile + t * 528 + c8 * 2), y); unpack8(*(const GAS v4u*)(zp + (size_t)t * 256 + c8), z);
        if (mulp) { float u[8]; unpack8(*(const GAS v4u*)(mulp + (size_t)t * 256 + c8), u);
#pragma unroll
            for (int e = 0; e < 8; ++e) y[e] *= u[e]; }
        float ss = 0.f;
#pragma unroll
        for (int e = 0; e < 8; ++e) ss += y[e] * y[e];
        ss += __shfl_xor(ss, 1); ss += __shfl_xor(ss, 2); ss += __shfl_xor(ss, 4); ss += __shfl_xor(ss, 8); ss += __shfl_xor(ss, 16);
        const float rstd = __builtin_amdgcn_rsqf(ss * (1.0f / 256.0f) + EPS);
#pragma unroll
        for (int e = 0; e < 8; ++e) y[e] = y[e] * rstd * silu(z[e]);
        *(GAS v4u*)(outp + (size_t)t * DM + c8) = pack8(y); }
}

__device__ __forceinline__ void mixer_a(LAS unsigned char* lds, const GAS bf16* proj, const GAS bf16* sguW, const GAS float* sgu_g, const GAS float* sgu_b, GAS bf16* ybuf, int T, int tid, int wid, int lane) {
    const int g = lane >> 4, o = lane & 15;
    const size_t R0 = (size_t)T * TILE;
    LAS float* rstdv = (LAS float*)(lds + L_RSTDV); LAS unsigned char* ytile = lds + L_YT;
    { const int jo = tid & 15, co = tid >> 4;
        LAS float* part = (LAS float*)(lds + L_RSTDV + 512);
        float sg[8]; { const f32x4 a = *(const GAS f32x4*)(sgu_g + 8 * co), b = *(const GAS f32x4*)(sgu_g + 8 * co + 4); sg[0] = a.x; sg[1] = a.y; sg[2] = a.z; sg[3] = a.w; sg[4] = b.x; sg[5] = b.y; sg[6] = b.z; sg[7] = b.w; }
        v4u rows[8]; float rs[8];
#pragma unroll
        for (int r = 0; r < 8; ++r) rows[r] = *(const GAS v4u*)(proj + (size_t)(OFF_AV >> 8) * PTILE + (R0 + 8 * jo + r) * 256 + 8 * co);
#pragma unroll
        for (int r = 0; r < 8; ++r) { float x[8]; unpack8(rows[r], x); float s = 0.f;
#pragma unroll
            for (int e = 0; e < 8; ++e) s += x[e] * x[e];
            s += __shfl_xor(s, 16); s += __shfl_xor(s, 32);
            if (lane < 16) part[wid * 128 + 8 * jo + r] = s; }
        __syncthreads();
        if (tid < 128) { float s = 0.f;
#pragma unroll
            for (int w = 0; w < 8; ++w) s += part[w * 128 + tid];
            rstdv[tid] = __builtin_amdgcn_rsqf(s * (1.0f / 256.0f) + EPS); }
        __syncthreads();
#pragma unroll
        for (int r = 0; r < 8; ++r) rs[r] = rstdv[8 * jo + r];
#pragma unroll
        for (int e = 0; e < 8; ++e) { float v[8];
#pragma unroll
            for (int r = 0; r < 8; ++r) { const unsigned w = rows[r][e >> 1]; v[r] = ((e & 1) ? bfhi(w) : bflo(w)) * rs[r] * sg[e]; }
            *(LAS v4u*)(lds + (8 * co + e) * 272 + 16 * jo) = pack8(v); }
    }
    __syncthreads();
    const int h = wid & 3, hf = wid >> 2;
    bf16x8 XW[4][4];
#pragma unroll
    for (int m = 0; m < 4; ++m)
#pragma unroll
        for (int kk = 0; kk < 4; ++kk) { XW[m][kk] = (bf16x8){0, 0, 0, 0, 0, 0, 0, 0}; if (kk < 2 || hf) XW[m][kk] = *(const GAS bf16x8*)(sguW + ((h * 128 + 64 * hf + 16 * m + o) * 128 + 8 * g) + 32 * kk); }
#pragma unroll
    for (int m = 0; m < 4; ++m) {
        f32x4 D[4];
#pragma unroll
        for (int n = 0; n < 4; ++n) D[n] = (f32x4){0.f, 0.f, 0.f, 0.f};
#pragma unroll
        for (int kk = 0; kk < 4; ++kk) if (kk < 2 || hf) {
#pragma unroll
            for (int n = 0; n < 4; ++n) { const bf16x8 Y = *(const LAS bf16x8*)(lds + (64 * h + 16 * n + o) * 272 + (32 * kk + 8 * g) * 2); D[n] = MFMA16(XW[m][kk], Y, D[n]); }
        }
        const int tb = 64 * hf + 16 * m + 4 * g;
        const f32x4 bias = *(const GAS f32x4*)(sgu_b + h * 128 + tb);
#pragma unroll
        for (int reg = 0; reg < 4; ++reg)
#pragma unroll
            for (int n = 0; n < 4; ++n) *(LAS bf16*)(ytile + (tb + reg) * 528 + (64 * h + 16 * n + o) * 2) = f2bf(D[n][reg] + bias[reg]);
    }
    __syncthreads();
    finish_rows(ytile, proj + (size_t)(OFF_AU >> 8) * PTILE + R0 * 256, proj + (size_t)(OFF_AZ >> 8) * PTILE + R0 * 256, ybuf + R0 * DM, tid);
}

__device__ __forceinline__ void mixer_b(LAS unsigned char* lds, const GAS bf16* proj, const GAS bf16* poolWT, const GAS float* pool_b, const GAS float* pool_s, GAS bf16* ybuf, int T, int tid, int wid, int lane) {
    const int g = lane >> 4, o = lane & 15, tt = T % TPS;
    const size_t R0 = (size_t)T * TILE;
    LAS unsigned char* ytile = lds + L_YT;
    {
        const int oc = tid & 31, seg = tid >> 5, grp = oc >> 3, win = 2 << grp, t0 = 8 * seg;
        const GAS bf16* base = proj + (size_t)(OFF_BX >> 8) * PTILE + R0 * 256 + 8 * oc;
        v4u R[23];
#pragma unroll
        for (int i = 0; i < 23; ++i) { const int t = t0 - 15 + i; R[i] = (v4u){0u, 0u, 0u, 0u}; if (i >= 16 - win && (t >= 0 || tt > 0)) R[i] = *(const GAS v4u*)(base + (long)t * 256); }
        float S[8];
#pragma unroll
        for (int e = 0; e < 8; ++e) S[e] = 0.f;
#pragma unroll
        for (int i = 0; i < 15; ++i) { float x[8]; unpack8(R[i], x);
#pragma unroll
            for (int e = 0; e < 8; ++e) S[e] += x[e]; }
        const int pos0 = tt * TILE + t0;
#pragma unroll
        for (int r = 0; r < 8; ++r) { float cur[8], pv[8], od[8]; unpack8(R[15 + r], cur);
            const int cnt = min(pos0 + r + 1, win); const float inv = 1.0f / (float)cnt;
#pragma unroll
            for (int e = 0; e < 8; ++e) { S[e] += cur[e]; pv[e] = S[e] * inv - cur[e]; }
            *(LAS v4u*)(lds + (t0 + r) * 528 + oc * 16) = pack8(pv);
            v4u ow = R[r];
            if (grp == 0) ow = R[14 + r]; else if (grp == 1) ow = R[12 + r]; else if (grp == 2) ow = R[8 + r];
            unpack8(ow, od);
#pragma unroll
            for (int e = 0; e < 8; ++e) S[e] -= od[e];
        }
    }
    __syncthreads();
    const int gg = wid & 3, hf = wid >> 2;
    bf16x8 Y[4][2]; float pb[4], ps[4];
#pragma unroll
    for (int n = 0; n < 4; ++n) { const int c = 64 * gg + 16 * n + o; pb[n] = pool_b[c]; ps[n] = pool_s[c];
#pragma unroll
        for (int kk = 0; kk < 2; ++kk) Y[n][kk] = *(const GAS bf16x8*)(poolWT + ((gg * 64 + 16 * n + o) * 64 + 32 * kk + 8 * g)); }
#pragma unroll 1
    for (int m = 0; m < 4; ++m) {
        f32x4 D[4];
#pragma unroll
        for (int n = 0; n < 4; ++n) D[n] = (f32x4){0.f, 0.f, 0.f, 0.f};
#pragma unroll
        for (int kk = 0; kk < 2; ++kk) { const bf16x8 X = *(const LAS bf16x8*)(lds + (64 * hf + 16 * m + o) * 528 + (64 * gg + 32 * kk + 8 * g) * 2);
#pragma unroll
            for (int n = 0; n < 4; ++n) D[n] = MFMA16(X, Y[n][kk], D[n]); }
        const int tb = 64 * hf + 16 * m + 4 * g;
#pragma unroll
        for (int reg = 0; reg < 4; ++reg)
#pragma unroll
            for (int n = 0; n < 4; ++n) *(LAS bf16*)(ytile + (tb + reg) * 528 + (64 * gg + 16 * n + o) * 2) = f2bf((D[n][reg] + pb[n]) * ps[n]);
    }
    __syncthreads();
    finish_rows(ytile, (const GAS bf16*)nullptr, proj + (size_t)(OFF_BZ >> 8) * PTILE + R0 * 256, ybuf + R0 * DM + 256, tid);
}

__device__ __forceinline__ void p3_tile(LAS unsigned char* lds, const GAS bf16* proj, const GAS bf16* hloc, const GAS unsigned char* Pbuf, const GAS float* aggL, const GAS float* aggH, const GAS unsigned* flags, GAS bf16* ybuf, int T, int tid, int wid, int lane) {
    const int tt = T % TPS; const size_t R0 = (size_t)T * TILE;
    LAS float* hin = (LAS float*)(lds + L_HIN);
    const int Tb = T - tt;
    if (tid < tt) { const GAS unsigned* fw = flags + 16 * (Tb + tid); unsigned sp = 0;
        while (__hip_atomic_load(fw, __ATOMIC_RELAXED, __HIP_MEMORY_SCOPE_AGENT) == 0u) { __builtin_amdgcn_s_sleep(2); if (++sp > (1u << 22)) break; } }
    __syncthreads();
    { float Lv[31], Hv[31], hcar = 0.f;
#pragma unroll
        for (int j = 0; j < 31; ++j) { Lv[j] = 0.f; Hv[j] = 0.f; if (j < tt) { Lv[j] = __hip_atomic_load(aggL + (size_t)(Tb + j) * 512 + tid, __ATOMIC_RELAXED, __HIP_MEMORY_SCOPE_AGENT); Hv[j] = __hip_atomic_load(aggH + (size_t)(Tb + j) * 512 + tid, __ATOMIC_RELAXED, __HIP_MEMORY_SCOPE_AGENT); } }
#pragma unroll
        for (int j = 0; j < 31; ++j) if (j < tt) hcar = Lv[j] * hcar + Hv[j];
        hin[tid] = hcar; }
    __syncthreads();
    float hi[8];
#pragma unroll
    for (int e = 0; e < 8; ++e) hi[e] = hin[8 * lane + e];
#pragma unroll 8
    for (int rr = 0; rr < 16; ++rr) { const int t = wid + 8 * rr; const size_t row = R0 + t;
        float hl[8], L[8], z[8], hv[8];
        v4u hw; v2u pw; if (t < 16 * PARK_M0) { hw = __builtin_nontemporal_load((const GAS v4u*)(hloc + row * 512 + 8 * lane)); pw = __builtin_nontemporal_load((const GAS v2u*)(Pbuf + row * 512 + 8 * lane)); } else { hw = *(const LAS v4u*)(lds + L_PARKH + (t - 16 * PARK_M0) * 1024 + 16 * lane); pw = *(const LAS v2u*)(lds + L_PARKP + (t - 16 * PARK_M0) * 512 + 8 * lane); }
        unpack8(hw, hl); {
#pragma unroll
            for (int e = 0; e < 8; ++e) L[e] = (float)(((e < 4 ? pw.x : pw.y) >> (8 * (e & 3))) & 0xffu) * (1.0f / 255.0f); } unpack8(*(const GAS v4u*)(proj + (size_t)((OFF_CZ >> 8) + (lane >> 5)) * PTILE + row * 256 + 8 * (lane & 31)), z);
        float ss = 0.f;
#pragma unroll
        for (int e = 0; e < 8; ++e) { hv[e] = hl[e] + L[e] * hi[e]; ss += hv[e] * hv[e]; }
        ss = wave_sum(ss); const float rstd = __builtin_amdgcn_rsqf(ss * (1.0f / 512.0f) + EPS);
#pragma unroll
        for (int e = 0; e < 8; ++e) hv[e] = hv[e] * rstd * silu(z[e]);
        *(GAS v4u*)(ybuf + row * DM + 512 + 8 * lane) = pack8(hv);
    }
    __syncthreads();
}

#define XB_TMO      128
#define XB_XCNT(j)  (256  + 64 * (j))
#define XB_XSUB(j)  (1280 + 64 * (j))
#define XB_XGEN(j)  (2304 + 64 * (j))
#define XB_TOP      3328
#define XB_TOPGEN   3392
#define XCD_BAR_WORDS 3456
#define XB_SPIN_CAP (1u << 18)

__device__ __forceinline__ unsigned xb_ld(unsigned* p)              { return __hip_atomic_load(p, __ATOMIC_RELAXED, __HIP_MEMORY_SCOPE_AGENT); }
__device__ __forceinline__ unsigned xb_add(unsigned* p, unsigned v) { return __hip_atomic_fetch_add(p, v, __ATOMIC_RELAXED, __HIP_MEMORY_SCOPE_AGENT); }
__device__ __forceinline__ unsigned xb_xcc_id() { return (unsigned)__builtin_amdgcn_s_getreg((3 << 11) | 20) & 0xFu; }
#define XB_SPIN(cond, bar) do { unsigned _sp = 0; while (cond) { __builtin_amdgcn_s_sleep(1); \
    if ((++_sp & 255u) == 0u) { if (xb_ld(&(bar)[XB_TMO])) break; if (_sp > XB_SPIN_CAP) { atomicAdd(&(bar)[XB_TMO], 1u); break; } } } } while (0)

struct XcdBarrier {
    unsigned* bar; unsigned x;
    volatile LAS unsigned* st;
};

__device__ __forceinline__ XcdBarrier xcd_barrier_post(unsigned* bar, volatile LAS unsigned* st) {
    XcdBarrier b; b.bar = bar; b.x = xb_xcc_id(); b.st = st;
    if (threadIdx.x == 0) (void)xb_add(&bar[XB_XCNT(b.x)], 1u);
    return b;
}
__device__ __forceinline__ void xcd_barrier_complete(unsigned* bar, unsigned x, unsigned& nloc, unsigned& nx) {
    const unsigned G = gridDim.x * gridDim.y * gridDim.z;
    unsigned sum, cnt, mine, sp = 0u;
    for (;;) {
        sum = 0u; cnt = 0u; mine = 0u;
#pragma unroll
        for (unsigned j = 0; j < 16; ++j) { const unsigned c = xb_ld(&bar[XB_XCNT(j)]); sum += c; cnt += (c > 0u) ? 1u : 0u; mine = (j == x) ? c : mine; }
        if (sum == G) break;
        __builtin_amdgcn_s_sleep(1);
        if ((++sp & 255u) == 0u) { if (xb_ld(&bar[XB_TMO])) break; if (sp > XB_SPIN_CAP) { atomicAdd(&bar[XB_TMO], 1u); break; } }
    }
    nloc = mine > 0u ? mine : 1u; nx = cnt > 0u ? cnt : 1u;
}

__device__ __forceinline__ void xcd_barrier(const XcdBarrier& b) {
    asm volatile("s_waitcnt vmcnt(0)" ::: "memory");
    __syncthreads();
    if (threadIdx.x == 0) {
        unsigned* bar = b.bar;
        __builtin_amdgcn_s_waitcnt(0);
        unsigned nloc = b.st[0], nx = b.st[1];
        if (nloc == 0u) { xcd_barrier_complete(bar, b.x, nloc, nx); b.st[0] = nloc; b.st[1] = nx; }
        const unsigned old = xb_add(&bar[XB_XSUB(b.x)], 1u);
        const unsigned gen = old / nloc;
        if (old + 1u == (gen + 1u) * nloc) {
            __builtin_amdgcn_fence(__ATOMIC_RELEASE, "agent");
            asm volatile("s_waitcnt vmcnt(0)" ::: "memory");
            const unsigned og = xb_add(&bar[XB_TOP], 1u);
            const unsigned tg = og / nx;
            if (og + 1u == (tg + 1u) * nx) xb_add(&bar[XB_TOPGEN], 1u);
            else XB_SPIN(xb_ld(&bar[XB_TOPGEN]) == tg, bar);
            __builtin_amdgcn_fence(__ATOMIC_ACQUIRE, "agent");
            xb_add(&bar[XB_XGEN(b.x)], 1u);
            asm volatile("s_waitcnt vmcnt(0)" ::: "memory");
        } else {
            XB_SPIN(xb_ld(&bar[XB_XGEN(b.x)]) == gen, bar);
            __builtin_amdgcn_fence(__ATOMIC_ACQUIRE, "agent");
            asm volatile("s_waitcnt vmcnt(0)" ::: "memory");
        }
    }
    __syncthreads();
}

#ifndef REP_P0
#define REP_P0 1
#endif
#ifndef REP_P1
#define REP_P1 1
#endif
#ifndef REP_P2
#define REP_P2 1
#endif
#ifndef REP_P3
#define REP_P3 1
#endif
#ifndef REP_C
#define REP_C 1
#endif
#ifndef REP_A
#define REP_A 1
#endif
#ifndef REP_B
#define REP_B 1
#endif
#ifndef REP_F
#define REP_F 1
#endif
typedef __attribute__((address_space(4))) const unsigned long long* kptr_t;
__device__ __forceinline__ unsigned long long karg(int i) { kptr_t k = (kptr_t)__builtin_amdgcn_kernarg_segment_ptr(); asm volatile("" : "+s"(k)); return k[i]; }
#define KIN(i) ((const GAS float*)karg(i))
#define KOUT ((GAS float*)karg(19))
#define KWS ((GAS unsigned char*)karg(20))

__global__ void __launch_bounds__(NTHR, 2) hybrid_fwd(Params p) {
    extern __shared__ __attribute__((aligned(16))) unsigned char lds_raw[];
    cg::grid_group grid = cg::this_grid();
    LAS unsigned char* lds = (LAS unsigned char*)lds_raw;
    if (threadIdx.x < 16) ((LAS unsigned*)(lds + L_MISC))[threadIdx.x] = 0u;
    __syncthreads();
    const XcdBarrier bar = xcd_barrier_post((unsigned*)(KWS + WS_CTL), (volatile LAS unsigned*)(lds + L_MISC));
    if (gridDim.x == 0x7fffffffu) grid.sync();
#define GRID_BAR() xcd_barrier(bar)
#ifdef TS_A
#define STAMP(k) do { if (threadIdx.x == 0) ((volatile LAS unsigned*)(lds + L_MISC))[2 + (k)] = (unsigned)__builtin_amdgcn_s_memrealtime(); } while (0)
#else
#define STAMP(k) do {} while (0)
#endif
    STAMP(0);
#ifndef NO_P0
    for (int rep0 = 0; rep0 < REP_P0; ++rep0)
    { int tid = threadIdx.x; asm volatile("" : "+v"(tid)); p0_prologue(p, lds, tid, tid & 63, __builtin_amdgcn_readfirstlane(tid >> 6)); }
#endif
    GRID_BAR();
    STAMP(1);
#pragma unroll 1
    for (int l = 0; l < 2; ++l) {
#ifndef NO_P1
        for (int rep1 = 0; rep1 < REP_P1; ++rep1)
        {
            GAS unsigned char* ws = KWS;
            pg8::Gemm g{(const bf16*)(ws + WS_H), (const bf16*)(ws + WS_WIN) + (size_t)l * DIN * DM, MROWS, DIN, DM};
            pg8::EpiProj E{(GAS bf16*)(ws + WS_PROJ), (const GAS float*)(ws + WS_ROWSS) + l * MROWS, DIN};
            if (l == 0 && gridDim.x == 256) {
                if (blockIdx.x >= 128) { int td = threadIdx.x; asm volatile("" : "+v"(td)); p0b_convert(KIN(0), ws, (int)blockIdx.x - 128, td & 63, __builtin_amdgcn_readfirstlane(td >> 6)); }
                else { int td = threadIdx.x; asm volatile("" : "+v"(td)); p0_deferred(KIN(2) + (size_t)DM * DIN, KIN(1) + DM, KIN(17), KIN(16), ws, lds, 0, 128, td & 63, __builtin_amdgcn_readfirstlane(td >> 6)); }
                __syncthreads();
                pg8::PanelOrder S{(int)blockIdx.x, (const unsigned*)(ws + WS_CTL + CTL_READY), 8u};
                pg8::gemm_phase<pg8::EpiProj, pg8::PanelOrder, true, true>(lds, g, S, E);
            } else { pg8::StaticOrder S; S.init(MROWS, DIN, gridDim.x, (int)blockIdx.x);
                pg8::gemm_phase<pg8::EpiProj, pg8::StaticOrder, true, true>(lds, g, S, E); }
        }
#endif
        GRID_BAR();
        if (l == 0) STAMP(2);
#ifndef NO_P2
        for (int rep2 = 0; rep2 < REP_P2; ++rep2)
        for (int T = blockIdx.x; T < NTILES; T += gridDim.x) {
            int tid = threadIdx.x; asm volatile("" : "+v"(tid)); const int lane = tid & 63, wave = __builtin_amdgcn_readfirstlane(tid >> 6);
            GAS unsigned char* ws = KWS; const GAS bf16* proj = (const GAS bf16*)(ws + WS_PROJ); GAS bf16* ybuf = (GAS bf16*)(ws + WS_Y);
            GAS bf16* hloc = (GAS bf16*)(ws + WS_SCAN); GAS float* aggL = (GAS float*)(ws + WS_AGG); GAS unsigned* flags = (GAS unsigned*)(ws + WS_CTL + CTL_FLAGS) + l * NTILES * 16;
            mixer_c(lds, proj, (const GAS bf16*)(ws + WS_WA) + l * 8 * 4096, (const GAS bf16*)(ws + WS_WX) + l * 8 * 4096, KIN(9) + l * 4 * 512, KIN(10) + l * 512,
                    KIN(12) + l * 512, KIN(14) + l * 512, KIN(15) + l * 512, hloc, (GAS unsigned char*)(hloc + (size_t)MROWS * 512), aggL, aggL + NTILES * 512, T, wave, lane);
            __syncthreads();
            if (l == 0) STAMP(3);
            if (tid == 0) __hip_atomic_store(flags + 16 * T, 1u, __ATOMIC_RELAXED, __HIP_MEMORY_SCOPE_AGENT);
            p3_tile(lds, proj, hloc, (const GAS unsigned char*)(hloc + (size_t)MROWS * 512), aggL, aggL + NTILES * 512, flags, ybuf, T, tid, wave, lane);
            mixer_a(lds, proj, (const GAS bf16*)(ws + WS_SGUW) + l * 4 * 128 * 128, KIN(3) + l * 256, KIN(5) + l * 512, ybuf, T, tid, wave, lane);
            mixer_b(lds, proj, (const GAS bf16*)(ws + WS_POOLW) + l * 4 * 4096, KIN(7) + l * 256, KIN(8) + l * 256, ybuf, T, tid, wave, lane);
            __syncthreads();
        }
#endif
#ifdef TS_A
        if (l == 1 && blockIdx.x == 0 && threadIdx.x == 0) { volatile LAS unsigned* st = (volatile LAS unsigned*)(lds + L_MISC) + 2; *(unsigned*)(KWS + WS_CTL + CTL_DBG) = st[TS_B] - st[TS_A]; }
#endif
        GRID_BAR();
        if (l == 0) STAMP(7);
#ifndef NO_P4
        {
            GAS unsigned char* ws = KWS; GAS float* out = KOUT;
            pg8::Gemm g{(const bf16*)(ws + WS_Y), (const bf16*)(ws + WS_WOUT) + (size_t)l * DM * DM, MROWS, DM, DM}; pg8::StaticOrder S; S.init(MROWS, DM, gridDim.x, (int)blockIdx.x);
            if (l == 0) { pg8::EpiOut E{(GAS bf16*)(ws + WS_H), (GAS float*)(ws + WS_ROWSS) + MROWS};
                pg8::gemm_phase<pg8::EpiOut, pg8::StaticOrder, true, true>(lds, g, S, E); }
            else { pg8::EpiOutFinal E{(const GAS bf16*)(ws + WS_H), out, (GAS float*)(ws + WS_ROWSS) + 2 * MROWS, (GAS unsigned*)(ws + WS_CTL + CTL_PANEL), KIN(18), (const GAS unsigned*)(ws + WS_CTL + CTL_DBG)};
                pg8::gemm_phase<pg8::EpiOutFinal, pg8::StaticOrder, true, true>(lds, g, S, E); }
        }
#endif
        if (l == 0) { GRID_BAR(); STAMP(8); }
    }
}

extern "C" void kernel_launch(void* const* d_in, const int* in_sizes, int n_in, void* d_out, int out_size, void* d_ws, size_t ws_size, hipStream_t stream) {
    static int grid = 0;
    if (grid == 0) {
        int dev = 0, cus = 0, per_cu = 0;
        if (n_in != 19 || out_size != MROWS * DM || ws_size < WS_END) { fprintf(stderr, "kernel_launch: unexpected shapes (n_in %d out %d ws %zu)\n", n_in, out_size, ws_size); grid = -1; return; }
        hipGetDevice(&dev); hipDeviceGetAttribute(&cus, hipDeviceAttributeMultiprocessorCount, dev);
        if (hipFuncSetAttribute((const void*)hybrid_fwd, hipFuncAttributeMaxDynamicSharedMemorySize, LDS_BYTES) != hipSuccess) { fprintf(stderr, "kernel_launch: hipFuncSetAttribute failed\n"); }
        if (hipOccupancyMaxActiveBlocksPerMultiprocessor(&per_cu, (const void*)hybrid_fwd, NTHR, LDS_BYTES) != hipSuccess || per_cu < 1) per_cu = 1;
        (void)hipGetLastError();
        if (per_cu > 1) per_cu = 1;
        grid = cus * per_cu;
        if (grid < 1) grid = 256;
        if (grid != 256) { fprintf(stderr, "kernel_launch: built for a 256-CU device (one workgroup per CU); got a grid of %d, nothing launched\n", grid); grid = -1; return; }
    }
    if (grid < 0) return;
    Params p{};
    for (int i = 0; i < 19; ++i) p.in[i] = (const float*)d_in[i];
    p.out = (float*)d_out; p.ws = (unsigned char*)d_ws;
    if (hipMemsetAsync((char*)d_ws + WS_CTL, 0, CTL_BYTES, stream) != hipSuccess) { fprintf(stderr, "kernel_launch: memset failed\n"); return; }
    void* args[] = {&p};
    hipError_t e = hipLaunchCooperativeKernel((const void*)hybrid_fwd, dim3(grid), dim3(NTHR), args, LDS_BYTES, stream);
    if (e != hipSuccess) fprintf(stderr, "kernel_launch: cooperative launch failed: %s (grid %d)\n", hipGetErrorString(e), grid);
}
```

```cpp
#include <hip/hip_runtime.h>
#include <hip/hip_cooperative_groups.h>
#include <cstdio>
#include <cstdint>
namespace cg = cooperative_groups;
namespace pg8 {
#define PG8_LAS __attribute__((address_space(3)))
typedef unsigned short bf16_t;
typedef short bf16x8 __attribute__((ext_vector_type(8)));
typedef float f32x4 __attribute__((ext_vector_type(4)));
typedef unsigned u32x4 __attribute__((ext_vector_type(4)));
constexpr int BM = 256, BK = 64, HALF = 128, HTB = HALF * BK * 2  , STAGE_BYTES = 8 * HTB, NXCD = 8, WGM = 8;

__host__ __device__ __forceinline__ int lds_byte(int r, int c) { const int st = (r >> 4) * 2 + (c >> 5), rr = r & 15, cc = c & 31, ob = rr * 64 + cc * 2; return st * 1024 + (ob ^ (((ob >> 9) & 1) << 5)); }
__host__ __device__ __forceinline__ void stage_rc(int b, int& R, int& C) { const int st = b / 1024, sb = b % 1024, swz = sb ^ (((sb >> 9) & 1) << 5); R = (st >> 1) * 16 + swz / 64; C = (st & 1) * 32 + (swz % 64) / 2; }
__host__ __device__ __forceinline__ int perm32(int rho) { const int n = rho >> 4, i = rho & 15; return 8 * (i >> 2) + 4 * n + (i & 3); }

struct Unit { int pm, pn; };
struct Gemm { const bf16_t* A; const bf16_t* Bt; int M, N, K; };

struct StaticOrder {
    int nM, nN, nwg, G, c;
    __host__ __device__ void init(int M, int N, int G_, int c_) { nM = M / BM; nN = N / BM; nwg = nM * nN; G = G_; c = c_; }
    __host__ __device__ bool next(int i, Unit& u) const {
        const long L = (long)i * G + c; if (L >= nwg) return false;
        int wgid = (int)L; { const int q = nwg / NXCD, r = nwg % NXCD, xcd = wgid % NXCD, off = wgid / NXCD; wgid = (xcd < r ? xcd * (q + 1) : r * (q + 1) + (xcd - r) * q) + off; }
        const int nig = WGM * nN, gid = wgid / nig, fm = gid * WGM, gsz = (nM - fm) < WGM ? (nM - fm) : WGM;
        u.pm = fm + ((wgid % nig) % gsz); u.pn = (wgid % nig) / gsz; return true;
    }
    __device__ __forceinline__ void a_ready(const Unit&) const {}
    __device__ __forceinline__ void done(const Unit&) const {}
};
struct PanelOrder {
    int c; const unsigned* ready; unsigned need;
    __device__ bool next(int i, Unit& u) const {
        const int late = c >> 7, cc = c & 127, slot = (cc & 7) * 16 + (cc >> 3);
        int base;
        if (!late) { if (i > 4) return false; base = (i == 0) ? 0 : (i == 1) ? 128 : (i == 2) ? 384 : (i == 3) ? 640 : 896; }
        else { if (i > 3) return false; base = 256 + 256 * i; }
        const int U = base + slot; u.pm = U / 9; u.pn = U - 9 * u.pm; return true;
    }
    __device__ __forceinline__ void a_ready(const Unit& u) const {
        if (threadIdx.x < 64) {
            unsigned sp = 0;
            while ((unsigned)__builtin_amdgcn_readfirstlane(__hip_atomic_load(ready + 64 * u.pm, __ATOMIC_RELAXED, __HIP_MEMORY_SCOPE_AGENT)) < need) { __builtin_amdgcn_s_sleep(2); if (++sp > (1u << 22)) break; }
            __builtin_amdgcn_fence(__ATOMIC_ACQUIRE, "agent");
            asm volatile("s_waitcnt vmcnt(0)" ::: "memory");
        }
        asm volatile("" ::: "memory"); __builtin_amdgcn_s_barrier(); asm volatile("" ::: "memory");
    }
    __device__ __forceinline__ void done(const Unit&) const {}
};

#if defined(__HIP_DEVICE_COMPILE__)
#define PG8_GAS __attribute__((address_space(1)))
#else
#define PG8_GAS
#endif
__device__ __forceinline__ unsigned cvt_pk_bf16(float lo, float hi) { unsigned r; asm volatile("v_cvt_pk_bf16_f32 %0, %1, %2" : "=v"(r) : "v"(lo), "v"(hi)); return r; }

struct EpiProj {
    static constexpr bool PERM = true, AFTER_DRAIN = false;
    PG8_GAS bf16_t* O; const PG8_GAS float* rowss; int ldc;
    __device__ __forceinline__ void operator()(const f32x4 (&acc)[2][2][4][2], const Unit& u, int wr, int wc, int fr, int fq) const {
        const int row0 = u.pm * BM + wr * 64 + fr, col0 = u.pn * BM + wc * 32 + 8 * fq;
#pragma unroll
        for (int ai = 0; ai < 2; ++ai)
#pragma unroll
            for (int m = 0; m < 4; ++m) {
                const int row = row0 + ai * HALF + m * 16;
                const float rs = __builtin_amdgcn_rsqf(rowss[row] * (1.0f / 1024.0f) + 1e-6f);
                PG8_GAS bf16_t* rowp = O + ((size_t)u.pn * 32768 + row) * 256 + (col0 - u.pn * BM);
#pragma unroll
                for (int bj = 0; bj < 2; ++bj) { const f32x4 v0 = acc[ai][bj][m][0] * rs, v1 = acc[ai][bj][m][1] * rs;
                    u32x4 w; w.x = cvt_pk_bf16(v0[0], v0[1]); w.y = cvt_pk_bf16(v0[2], v0[3]); w.z = cvt_pk_bf16(v1[0], v1[1]); w.w = cvt_pk_bf16(v1[2], v1[3]);
                    *(PG8_GAS u32x4*)(rowp + bj * HALF) = w; }
            }
    }
};
struct EpiOut {
    static constexpr bool PERM = true, AFTER_DRAIN = false;
    PG8_GAS bf16_t* hb; PG8_GAS float* rowss;
    __device__ __forceinline__ void operator()(const f32x4 (&acc)[2][2][4][2], const Unit& u, int wr, int wc, int fr, int fq) const {
        const int row0 = u.pm * BM + wr * 64 + fr, col0 = u.pn * BM + wc * 32 + 8 * fq;
#pragma unroll
        for (int ai = 0; ai < 2; ++ai) {
            u32x4 rw[4][2];
#pragma unroll
            for (int m = 0; m < 4; ++m)
#pragma unroll
                for (int bj = 0; bj < 2; ++bj) rw[m][bj] = *(const PG8_GAS u32x4*)(hb + (size_t)(row0 + ai * HALF + m * 16) * 1024 + col0 + bj * HALF);
#pragma unroll
            for (int m = 0; m < 4; ++m) {
                const int row = row0 + ai * HALF + m * 16;
                const size_t off = (size_t)row * 1024 + col0;
                float ss = 0.f;
#pragma unroll
                for (int bj = 0; bj < 2; ++bj) {
                    const u32x4 w0 = rw[m][bj];
                    const f32x4 r0 = {__uint_as_float(w0.x << 16), __uint_as_float(w0.x & 0xffff0000u), __uint_as_float(w0.y << 16), __uint_as_float(w0.y & 0xffff0000u)};
                    const f32x4 r1 = {__uint_as_float(w0.z << 16), __uint_as_float(w0.z & 0xffff0000u), __uint_as_float(w0.w << 16), __uint_as_float(w0.w & 0xffff0000u)};
                    const f32x4 v0 = acc[ai][bj][m][0] + r0, v1 = acc[ai][bj][m][1] + r1;
                    ss += (v0[0] * v0[0] + v0[1] * v0[1]) + (v0[2] * v0[2] + v0[3] * v0[3]) + (v1[0] * v1[0] + v1[1] * v1[1]) + (v1[2] * v1[2] + v1[3] * v1[3]);
                    u32x4 w; w.x = cvt_pk_bf16(v0[0], v0[1]); w.y = cvt_pk_bf16(v0[2], v0[3]); w.z = cvt_pk_bf16(v1[0], v1[1]); w.w = cvt_pk_bf16(v1[2], v1[3]);
                    *(PG8_GAS u32x4*)(hb + off + bj * HALF) = w;
                }
                ss += __shfl_xor(ss, 16); ss += __shfl_xor(ss, 32);
                if (fq == 0) __hip_atomic_fetch_add(rowss + row, ss, __ATOMIC_RELAXED, __HIP_MEMORY_SCOPE_AGENT);
            }
        }
    }
};
struct EpiOutFinal {
    static constexpr bool PERM = true, AFTER_DRAIN = false;
    const PG8_GAS bf16_t* resid; PG8_GAS float* out; PG8_GAS float* rowss; PG8_GAS unsigned* cnt; const PG8_GAS float* fg; const PG8_GAS unsigned* dbg;
    __device__ __forceinline__ void operator()(f32x4 (&acc)[2][2][4][2], const Unit& u, int wr, int wc, int fr, int fq) const {
        const int row0 = u.pm * BM + wr * 64 + fr, col0 = u.pn * BM + wc * 32 + 8 * fq;
#pragma unroll
        for (int am = 0; am < 4; ++am) { const int ai = am >> 1;
            f32x4 r[4][2][2];
#pragma unroll
            for (int m = 2 * (am & 1); m < 2 * (am & 1) + 2; ++m)
#pragma unroll
                for (int bj = 0; bj < 2; ++bj) { const size_t off = (size_t)(row0 + ai * HALF + m * 16) * 1024 + col0 + bj * HALF;
                    const u32x4 w = __builtin_nontemporal_load((const PG8_GAS u32x4*)(resid + off));
                    r[m][bj][0] = (f32x4){__uint_as_float(w.x << 16), __uint_as_float(w.x & 0xffff0000u), __uint_as_float(w.y << 16), __uint_as_float(w.y & 0xffff0000u)};
                    r[m][bj][1] = (f32x4){__uint_as_float(w.z << 16), __uint_as_float(w.z & 0xffff0000u), __uint_as_float(w.w << 16), __uint_as_float(w.w & 0xffff0000u)}; }
#pragma unroll
            for (int m = 2 * (am & 1); m < 2 * (am & 1) + 2; ++m) {
                const int row = row0 + ai * HALF + m * 16;
                float ss = 0.f;
#pragma unroll
                for (int bj = 0; bj < 2; ++bj) {
                    const f32x4 v0 = acc[ai][bj][m][0] + r[m][bj][0], v1 = acc[ai][bj][m][1] + r[m][bj][1];
                    acc[ai][bj][m][0] = v0; acc[ai][bj][m][1] = v1;
                    ss += (v0[0] * v0[0] + v0[1] * v0[1]) + (v0[2] * v0[2] + v0[3] * v0[3]) + (v1[0] * v1[0] + v1[1] * v1[1]) + (v1[2] * v1[2] + v1[3] * v1[3]);
                }
                ss += __shfl_xor(ss, 16); ss += __shfl_xor(ss, 32);
                if (fq == 0) __hip_atomic_fetch_add(rowss + row, ss, __ATOMIC_RELAXED, __HIP_MEMORY_SCOPE_AGENT);
            }
        }
        asm volatile("s_waitcnt vmcnt(0)" ::: "memory");
        PG8_GAS unsigned* c = cnt + 64 * u.pm;
        if ((threadIdx.x & 63) == 0) __hip_atomic_fetch_add(c, 1u, __ATOMIC_RELAXED, __HIP_MEMORY_SCOPE_AGENT);
        { unsigned sp = 0; while ((unsigned)__builtin_amdgcn_readfirstlane(__hip_atomic_load(c, __ATOMIC_RELAXED, __HIP_MEMORY_SCOPE_AGENT)) < 32u) { __builtin_amdgcn_s_sleep(2); if (++sp > (1u << 22)) break; } }
        asm volatile("" ::: "memory");
        f32x4 g0[2], g1[2];
#ifdef TS_A
        const float dlt = (float)dbg[0] * 1e-7f;
#else
        const float dlt = 0.f;
#endif
#pragma unroll
        for (int bj = 0; bj < 2; ++bj) { g0[bj] = *(const PG8_GAS f32x4*)(fg + col0 + bj * HALF); g1[bj] = *(const PG8_GAS f32x4*)(fg + col0 + bj * HALF + 4); }
#pragma unroll
        for (int ai = 0; ai < 2; ++ai)
#pragma unroll
            for (int m = 0; m < 4; ++m) {
                const int row = row0 + ai * HALF + m * 16;
                const float rs = __builtin_amdgcn_rsqf(__hip_atomic_load(rowss + row, __ATOMIC_RELAXED, __HIP_MEMORY_SCOPE_AGENT) * (1.0f / 1024.0f) + 1e-6f);
                PG8_GAS float* o = out + (size_t)row * 1024 + col0;
#pragma unroll
                for (int bj = 0; bj < 2; ++bj) { *(PG8_GAS f32x4*)(o + bj * HALF) = acc[ai][bj][m][0] * rs * g0[bj] + dlt; *(PG8_GAS f32x4*)(o + bj * HALF + 4) = acc[ai][bj][m][1] * rs * g1[bj] + dlt; }
            }
    }
};

template <class Epi, class Sched, bool ALIGN_EPI = false, bool SP2 = false>
__device__ __forceinline__ void gemm_phase(PG8_LAS unsigned char* lds, const Gemm g, const Sched& S, const Epi& E) {
    int tid_ = threadIdx.x; asm volatile("" : "+v"(tid_));
    const int tid = tid_, wid = __builtin_amdgcn_readfirstlane(tid >> 6), lane = tid & 63, wr = wid >> 2, wc = wid & 3, fr = lane & 15, fq = lane >> 4;
    const int K = g.K, nt = K / BK;
    unsigned voffA[2], voffB[2];
#pragma unroll
    for (int i = 0; i < 2; ++i) { int R, C; stage_rc(tid * 16 + i * 8192, R, C); const int Rb = Epi::PERM ? ((R & ~31) + perm32(R & 31)) : R;
        voffA[i] = (unsigned)(R * K + C) * 2u; voffB[i] = (unsigned)(Rb * K + C) * 2u; }
    const size_t kstep = (size_t)(BK * 2);
    const size_t hstep = (size_t)HALF * K * 2;
    const size_t tstep = 2 * hstep;
    const unsigned ldsw = (unsigned)wid * 1024u;
    const int aoff = lds_byte(wr * 64 + fr, fq * 8), boff = lds_byte(wc * 32 + fr, fq * 8);
#define PG8_SA(b, h) (((b) * 2 + (h)) * HTB)
#define PG8_SB(b, h) ((4 + (b) * 2 + (h)) * HTB)
#define PG8_STAGE(bufoff, gbase, voff) do { _Pragma("unroll") for (int _i = 0; _i < 2; ++_i) \
        __builtin_amdgcn_global_load_lds((const unsigned*)((const char*)(gbase) + (voff)[_i]), (PG8_LAS unsigned*)(lds + (bufoff) + ldsw + _i * 8192), 16, 0, 0); } while (0)
#define PG8_LDA(dst, b, h) do { _Pragma("unroll") for (int m = 0; m < 4; ++m) _Pragma("unroll") for (int k = 0; k < 2; ++k) dst[m][k] = *(const PG8_LAS bf16x8*)(lds + PG8_SA(b, h) + aoff + m * 2048 + k * 1024); } while (0)
#define PG8_LDB(dst, b, h) do { _Pragma("unroll") for (int n = 0; n < 2; ++n) _Pragma("unroll") for (int k = 0; k < 2; ++k) dst[n][k] = *(const PG8_LAS bf16x8*)(lds + PG8_SB(b, h) + boff + n * 2048 + k * 1024); } while (0)
#define PG8_MMA(ai, bj, At, Bt) do { __builtin_amdgcn_s_setprio(1); _Pragma("unroll") for (int m = 0; m < 4; ++m) _Pragma("unroll") for (int n = 0; n < 2; ++n) _Pragma("unroll") for (int k = 0; k < 2; ++k) \
        acc[ai][bj][m][n] = __builtin_amdgcn_mfma_f32_16x16x32_bf16(Bt[n][k], At[m][k], acc[ai][bj][m][n], 0, 0, 0); __builtin_amdgcn_s_setprio(0); } while (0)
#define PG8_WAIT_V(n) asm volatile("s_waitcnt vmcnt(" #n ")" ::: "memory")
#define PG8_WAIT_L(n) asm volatile("s_waitcnt lgkmcnt(" #n ")" ::: "memory")
#define PG8_BAR __builtin_amdgcn_s_barrier()
#define PG8_SCHED __builtin_amdgcn_sched_barrier(0)
    Unit cur, nxt; int ui = 0;
    if (!S.next(0, cur)) return;
    f32x4 acc[2][2][4][2];
#pragma unroll
    for (int a = 0; a < 2; ++a)
#pragma unroll
        for (int b = 0; b < 2; ++b)
#pragma unroll
            for (int m = 0; m < 4; ++m)
#pragma unroll
                for (int n = 0; n < 2; ++n) acc[a][b][m][n] = (f32x4){0.f, 0.f, 0.f, 0.f};
    bf16x8 At[4][2], B0[2][2], B1[2][2];
    const char* cA = (const char*)g.A + (size_t)cur.pm * tstep; const char* cB = (const char*)g.Bt + (size_t)cur.pn * tstep;
    S.a_ready(cur);
    if constexpr (SP2) {
        PG8_STAGE(PG8_SB(0, 0), cB, voffB); PG8_STAGE(PG8_SB(0, 1), cB + hstep, voffB); PG8_STAGE(PG8_SA(0, 0), cA, voffA); PG8_STAGE(PG8_SA(0, 1), cA + hstep, voffA);
        if (wr == 1) PG8_BAR;
        PG8_WAIT_V(2); PG8_BAR;
        PG8_STAGE(PG8_SB(1, 0), cB + kstep, voffB); PG8_STAGE(PG8_SA(1, 0), cA + kstep, voffA); PG8_STAGE(PG8_SB(1, 1), cB + hstep + kstep, voffB);
        PG8_WAIT_V(6); PG8_BAR;
    } else {
        PG8_STAGE(PG8_SB(0, 0), cB, voffB); PG8_STAGE(PG8_SA(0, 0), cA, voffA); PG8_STAGE(PG8_SB(0, 1), cB + hstep, voffB); PG8_STAGE(PG8_SA(0, 1), cA + hstep, voffA);
        if (wr == 1) PG8_BAR;
        PG8_WAIT_V(4); PG8_BAR;
        PG8_STAGE(PG8_SB(1, 0), cB + kstep, voffB); PG8_STAGE(PG8_SA(1, 0), cA + kstep, voffA); PG8_STAGE(PG8_SB(1, 1), cB + hstep + kstep, voffB);
        PG8_WAIT_V(6); PG8_BAR;
    }
    for (;;) {
        const bool has_next = S.next(ui + 1, nxt);
        const char* nA = has_next ? (const char*)g.A + (size_t)nxt.pm * tstep : cA; const char* nB = has_next ? (const char*)g.Bt + (size_t)nxt.pn * tstep : cB;
        for (int t = 0; t < nt; t += 2) {
            const bool last = (t == nt - 2);
            const char* a1 = cA + (size_t)(t + 1) * kstep;
            const char* a2 = last ? nA : cA + (size_t)(t + 2) * kstep; const char* b2 = last ? nB : cB + (size_t)(t + 2) * kstep;
            const char* a3 = a2 + kstep; const char* b3 = b2 + kstep;
            if (last && has_next) S.a_ready(nxt);
            if constexpr (SP2) {
            PG8_LDB(B0, 0, 0); PG8_LDB(B1, 0, 1); PG8_SCHED; PG8_LDA(At, 0, 0); PG8_STAGE(PG8_SA(1, 1), a1 + hstep, voffA);
            PG8_WAIT_V(8); PG8_WAIT_L(0); PG8_BAR; PG8_MMA(0, 0, At, B0); PG8_MMA(0, 1, At, B1); PG8_BAR; PG8_SCHED;
            PG8_LDA(At, 0, 1); PG8_STAGE(PG8_SB(0, 0), b2, voffB); PG8_STAGE(PG8_SB(0, 1), b2 + hstep, voffB); PG8_STAGE(PG8_SA(0, 0), a2, voffA);
            PG8_WAIT_V(8); PG8_WAIT_L(0); PG8_BAR; PG8_MMA(1, 0, At, B0); PG8_MMA(1, 1, At, B1); PG8_BAR; PG8_SCHED;
            PG8_LDB(B0, 1, 0); PG8_LDB(B1, 1, 1); PG8_SCHED; PG8_LDA(At, 1, 0); PG8_STAGE(PG8_SA(0, 1), a2 + hstep, voffA);
            PG8_WAIT_V(8); PG8_WAIT_L(0); PG8_BAR; PG8_MMA(0, 0, At, B0); PG8_MMA(0, 1, At, B1); PG8_BAR; PG8_SCHED;
            PG8_LDA(At, 1, 1); PG8_STAGE(PG8_SB(1, 0), b3, voffB); PG8_STAGE(PG8_SB(1, 1), b3 + hstep, voffB); PG8_STAGE(PG8_SA(1, 0), a3, voffA);
            PG8_WAIT_V(8); PG8_WAIT_L(0); PG8_BAR; PG8_MMA(1, 0, At, B0); PG8_MMA(1, 1, At, B1); PG8_BAR; PG8_SCHED;
            } else {
            PG8_LDB(B0, 0, 0); PG8_SCHED; PG8_LDA(At, 0, 0); PG8_STAGE(PG8_SA(1, 1), a1 + hstep, voffA);
            PG8_WAIT_L(8); PG8_BAR; PG8_WAIT_L(0); PG8_MMA(0, 0, At, B0); PG8_BAR; PG8_SCHED;
            PG8_LDB(B1, 0, 1); PG8_STAGE(PG8_SB(0, 0), b2, voffB);
            PG8_BAR; PG8_WAIT_L(0); PG8_MMA(0, 1, At, B1); PG8_BAR;
            PG8_LDA(At, 0, 1); PG8_STAGE(PG8_SA(0, 0), a2, voffA);
            PG8_BAR; PG8_WAIT_L(0); PG8_MMA(1, 0, At, B0); PG8_BAR; PG8_SCHED;
            PG8_STAGE(PG8_SB(0, 1), b2 + hstep, voffB);
            PG8_WAIT_V(6); PG8_BAR; PG8_MMA(1, 1, At, B1); PG8_BAR;
            PG8_LDB(B0, 1, 0); PG8_SCHED; PG8_LDA(At, 1, 0); PG8_STAGE(PG8_SA(0, 1), a2 + hstep, voffA);
            PG8_WAIT_L(8); PG8_BAR; PG8_WAIT_L(0); PG8_MMA(0, 0, At, B0); PG8_BAR; PG8_SCHED;
            PG8_LDB(B1, 1, 1); PG8_STAGE(PG8_SB(1, 0), b3, voffB);
            PG8_BAR; PG8_WAIT_L(0); PG8_MMA(0, 1, At, B1); PG8_BAR;
            PG8_LDA(At, 1, 1); PG8_STAGE(PG8_SA(1, 0), a3, voffA);
            PG8_BAR; PG8_WAIT_L(0); PG8_MMA(1, 0, At, B0); PG8_BAR; PG8_SCHED;
            PG8_STAGE(PG8_SB(1, 1), b3 + hstep, voffB);
            PG8_WAIT_V(6); PG8_BAR; PG8_MMA(1, 1, At, B1); PG8_BAR;
            }
        }
        if constexpr (ALIGN_EPI) { if (wr == 0) PG8_BAR; }
        if constexpr (!Epi::AFTER_DRAIN) { E(acc, cur, wr, wc, fr, fq); S.done(cur); }
        if (!has_next) break;
#pragma unroll
        for (int a = 0; a < 2; ++a)
#pragma unroll
            for (int b = 0; b < 2; ++b)
#pragma unroll
                for (int m = 0; m < 4; ++m)
#pragma unroll
                    for (int n = 0; n < 2; ++n) acc[a][b][m][n] = (f32x4){0.f, 0.f, 0.f, 0.f};
        cur = nxt; cA = nA; cB = nB; ++ui;
        if constexpr (ALIGN_EPI) { if (wr == 1) PG8_BAR; }
    }
    PG8_WAIT_V(0);
    if constexpr (!ALIGN_EPI) { if (wr == 0) PG8_BAR; }
    PG8_BAR;
    if constexpr (Epi::AFTER_DRAIN) { E.fused(acc, cur, wr, wc, fr, fq, lds, wid, lane); S.done(cur); }
#undef PG8_SA
#undef PG8_SB
#undef PG8_STAGE
#undef PG8_LDA
#undef PG8_LDB
#undef PG8_MMA
#undef PG8_WAIT_V
#undef PG8_WAIT_L
#undef PG8_BAR
#undef PG8_SCHED
}
}

constexpr int NWAVES = 8, NTHR = 512;
constexpr int MROWS = 32768, DM = 1024, DIN = 2304, SEQ = 4096, TILE = 128, NTILES = MROWS / TILE, TPS = SEQ / TILE;
constexpr size_t PTILE = (size_t)MROWS * 256;
constexpr int OFF_AU = 0, OFF_AV = 256, OFF_AZ = 512, OFF_BX = 768, OFF_BZ = 1024, OFF_CX = 1280, OFF_CZ = 1792;
constexpr float EPS = 1e-6f;
constexpr size_t MiB = 1u << 20;
constexpr size_t WS_WIN = 0;
constexpr size_t WS_WOUT = 9 * MiB;
constexpr size_t WS_SGUW = 13 * MiB;
constexpr size_t WS_POOLW = 13 * MiB + 256 * 1024;
constexpr size_t WS_WA = 13 * MiB + 512 * 1024;
constexpr size_t WS_WX = 13 * MiB + 768 * 1024;
constexpr size_t WS_ROWSS = 14 * MiB;
constexpr size_t WS_CTL = 14 * MiB + 512 * 1024, CTL_PANEL = 16384, CTL_FLAGS = 16384 + 32768, CTL_DBG = 16384 + 32768 + 32768, CTL_READY = 16384 + 32768 + 32768 + 256, CTL_BYTES = 16384 + 32768 + 32768 + 256 + 32768;
constexpr size_t WS_AGG = 15 * MiB;
constexpr size_t WS_H = 16 * MiB;
constexpr size_t WS_PROJ = 80 * MiB;
constexpr size_t WS_Y = 224 * MiB;
constexpr size_t WS_SCAN = 288 * MiB;
constexpr size_t WS_END = 352 * MiB;
constexpr int LDS_BYTES = 163840;

#define LAS __attribute__((address_space(3)))
#if defined(__HIP_DEVICE_COMPILE__)
#define GAS __attribute__((address_space(1)))
#else
#define GAS
#endif
typedef unsigned short bf16;
typedef unsigned v4u __attribute__((ext_vector_type(4)));
typedef unsigned v2u __attribute__((ext_vector_type(2)));
typedef float f32x4 __attribute__((ext_vector_type(4)));
typedef short bf16x8 __attribute__((ext_vector_type(8)));
typedef float f32x2 __attribute__((ext_vector_type(2)));

__device__ __forceinline__ unsigned pk2(float lo, float hi) { return pg8::cvt_pk_bf16(lo, hi); }
__device__ __forceinline__ float bflo(unsigned w) { return __uint_as_float(w << 16); }
__device__ __forceinline__ float bfhi(unsigned w) { return __uint_as_float(w & 0xffff0000u); }
__device__ __forceinline__ float bf2f(bf16 b) { return __uint_as_float(((unsigned)b) << 16); }
__device__ __forceinline__ bf16 f2bf(float f) { return (bf16)(pk2(f, 0.f) & 0xffffu); }
__device__ __forceinline__ float fexp(float x) { return __builtin_amdgcn_exp2f(x * 1.4426950408889634f); }
__device__ __forceinline__ float sigm(float x) { return __builtin_amdgcn_rcpf(1.0f + fexp(-x)); }
__device__ __forceinline__ float silu(float x) { return x * sigm(x); }
__device__ __forceinline__ float wave_sum(float v) {
#pragma unroll
    for (int o = 1; o < 64; o <<= 1) v += __shfl_xor(v, o);
    return v;
}
__device__ __forceinline__ void unpack8(const v4u w, float (&x)[8]) {
    x[0] = bflo(w.x); x[1] = bfhi(w.x); x[2] = bflo(w.y); x[3] = bfhi(w.y); x[4] = bflo(w.z); x[5] = bfhi(w.z); x[6] = bflo(w.w); x[7] = bfhi(w.w);
}
__device__ __forceinline__ v4u pack8(const float (&x)[8]) { v4u w; w.x = pk2(x[0], x[1]); w.y = pk2(x[2], x[3]); w.z = pk2(x[4], x[5]); w.w = pk2(x[6], x[7]); return w; }
#define MFMA16(a, b, c) __builtin_amdgcn_mfma_f32_16x16x32_bf16((a), (b), (c), 0, 0, 0)

struct Params {
    const float* in[19];
    float* out; unsigned char* ws;
};

__device__ __forceinline__ void p0_transpose_item(const GAS float* W, const GAS float* gk, int K, int N, GAS bf16* WT, LAS float* scr, int item, int lane) {
    const int nblk = N / 32, kb = item / nblk, nb = item % nblk, k0 = 64 * kb, n0 = 32 * nb;
    float wv[32];
#pragma unroll
    for (int i = 0; i < 32; ++i) { const int kk = 2 * i + (lane >> 5); wv[i] = W[(size_t)(k0 + kk) * N + n0 + (lane & 31)]; }
    const float g0 = gk[k0 + (lane & 31) + 0], g1 = gk[k0 + (lane & 31) + 32];
#pragma unroll
    for (int i = 0; i < 32; ++i) { const int kk = 2 * i + (lane >> 5); const float gsel = __shfl((2 * i < 32) ? g0 : g1, (lane & 32) + ((2 * i + (lane >> 5)) & 31)); scr[kk * 33 + (lane & 31)] = wv[i] * gsel; }
    asm volatile("s_waitcnt lgkmcnt(0)" ::: "memory");
    const int c = lane & 7;
#pragma unroll
    for (int j = 0; j < 4; ++j) { const int n = (lane >> 3) + 8 * j; const LAS float* s = scr + (8 * c) * 33 + n;
        v4u o; o.x = pk2(s[0 * 33], s[1 * 33]); o.y = pk2(s[2 * 33], s[3 * 33]); o.z = pk2(s[4 * 33], s[5 * 33]); o.w = pk2(s[6 * 33], s[7 * 33]);
        *(GAS v4u*)(WT + (size_t)(n0 + n) * K + k0 + 8 * c) = o; }
    asm volatile("s_waitcnt lgkmcnt(0)" ::: "memory");
}
__device__ __forceinline__ void p0_prologue(const Params& p, LAS unsigned char* lds, int tid, int lane, int wave) {
    unsigned char* ws = p.ws;
    LAS float* scr = (LAS float*)(lds + wave * 16384);
    const int G = gridDim.x, gw = blockIdx.x * NWAVES + wave, NGW = G * NWAVES;
    constexpr int I_IN = (DM / 64) * (DIN / 32), I_OUT = (DM / 64) * (DM / 32);
    for (int it = gw; it < I_IN; it += NGW)
        p0_transpose_item((const GAS float*)p.in[2], (const GAS float*)p.in[1], DM, DIN, (GAS bf16*)(ws + WS_WIN), scr, it, lane);
    const int gt = blockIdx.x * NTHR + tid, NGT = G * NTHR;
    for (int i = gt; i < 2 * 4 * 128 * 128; i += NGT) { const int jj = i & 127, ii = (i >> 7) & 127; const float m = ((jj >> 6) <= (ii >> 6)) ? 1.f : 0.f; ((GAS bf16*)(ws + WS_SGUW))[i] = f2bf(p.in[4][i] * m); }
    for (int i = gt; i < 2 * 4 * 64 * 64; i += NGT) { const int ii = i & 63, o = (i >> 6) & 63, lg = i >> 12; ((GAS bf16*)(ws + WS_POOLW))[i] = f2bf(p.in[6][(lg * 64 + ii) * 64 + o]); }
    for (int i = gt; i < 2 * 8 * 64 * 64; i += NGT) { const int ii = i & 63, o = (i >> 6) & 63, lh = i >> 12;
        ((GAS bf16*)(ws + WS_WA))[i] = f2bf(p.in[11][(lh * 64 + ii) * 64 + o]); ((GAS bf16*)(ws + WS_WX))[i] = f2bf(p.in[13][(lh * 64 + ii) * 64 + o]); }
    GAS float* rowss = (GAS float*)(ws + WS_ROWSS);
    for (int i = gt; i < 2 * MROWS; i += NGT) rowss[MROWS + i] = 0.f;
    {   const GAS float* x = (const GAS float*)p.in[0]; GAS bf16* hb = (GAS bf16*)(ws + WS_H);
        for (int m = gw; m < 4096; m += NGW) { const f32x4* xr = (const GAS f32x4*)(x + (size_t)m * DM) + lane; f32x4 v[4]; float s = 0.f;
#pragma unroll
            for (int j = 0; j < 4; ++j) v[j] = __builtin_nontemporal_load(xr + 64 * j);
            GAS unsigned long long* o8 = (GAS unsigned long long*)(hb + (size_t)m * DM) + lane;
#pragma unroll
            for (int j = 0; j < 4; ++j) { const f32x4 w = v[j]; s += (w.x * w.x + w.y * w.y) + (w.z * w.z + w.w * w.w); o8[64 * j] = (unsigned long long)pk2(w.x, w.y) | ((unsigned long long)pk2(w.z, w.w) << 32); }
            s = wave_sum(s);
            if (lane == 0) rowss[m] = s; }
        if (blockIdx.x == 0 && tid < 16) __hip_atomic_store((GAS unsigned*)(ws + WS_CTL + CTL_READY) + 64 * tid, 8u, __ATOMIC_RELAXED, __HIP_MEMORY_SCOPE_AGENT);
    }
}
__device__ __forceinline__ void p0b_convert(const GAS float* x, GAS unsigned char* ws, int lb, int lane, int wave) {
    GAS bf16* hb = (GAS bf16*)(ws + WS_H); GAS float* rowss = (GAS float*)(ws + WS_ROWSS); GAS unsigned* ready = (GAS unsigned*)(ws + WS_CTL + CTL_READY);
    const int q = lb >> 3, mem = lb & 7;
#pragma unroll 1
    for (int k = 1; k < 8; ++k) {
        const int pnl = 16 * k + q; const size_t r0 = (size_t)pnl * 256 + 32 * mem + 4 * wave;
        f32x4 v[4][4];
#pragma unroll
        for (int qq = 0; qq < 4; ++qq) { const f32x4* xr = (const GAS f32x4*)(x + (r0 + qq) * DM) + lane;
#pragma unroll
            for (int j = 0; j < 4; ++j) v[qq][j] = __builtin_nontemporal_load(xr + 64 * j); }
#pragma unroll
        for (int qq = 0; qq < 4; ++qq) { float s = 0.f; GAS unsigned long long* o8 = (GAS unsigned long long*)(hb + (r0 + qq) * DM) + lane;
#pragma unroll
            for (int j = 0; j < 4; ++j) { const f32x4 w = v[qq][j]; s += (w.x * w.x + w.y * w.y) + (w.z * w.z + w.w * w.w);
                __hip_atomic_store(o8 + 64 * j, (unsigned long long)pk2(w.x, w.y) | ((unsigned long long)pk2(w.z, w.w) << 32), __ATOMIC_RELAXED, __HIP_MEMORY_SCOPE_AGENT); }
            s = wave_sum(s);
            if (lane == 0) __hip_atomic_store(rowss + r0 + qq, s, __ATOMIC_RELAXED, __HIP_MEMORY_SCOPE_AGENT); }
        asm volatile("s_waitcnt vmcnt(0)" ::: "memory");
        __syncthreads();
        if (threadIdx.x == 0) __hip_atomic_fetch_add(ready + 64 * pnl, 1u, __ATOMIC_RELAXED, __HIP_MEMORY_SCOPE_AGENT);
    }
}

__device__ __forceinline__ void p0_deferred(const GAS float* w_in1, const GAS float* g1, const GAS float* w_out, const GAS float* bg, GAS unsigned char* ws, LAS unsigned char* lds, int first, int nb, int lane, int wave) {
    LAS float* scr = (LAS float*)(lds + wave * 16384);
    const int gw = ((int)blockIdx.x - first) * NWAVES + wave, NGW = nb * NWAVES;
    constexpr int I_IN = (DM / 64) * (DIN / 32), I_OUT = (DM / 64) * (DM / 32);
    for (int it = gw; it < I_IN + 2 * I_OUT; it += NGW) {
        int r = it;
        if (r < I_IN) { p0_transpose_item(w_in1, g1, DM, DIN, (GAS bf16*)(ws + WS_WIN) + (size_t)DIN * DM, scr, r, lane); continue; }
        r -= I_IN; { const int l = r / I_OUT; r -= l * I_OUT;
            p0_transpose_item(w_out + (size_t)l * DM * DM, bg + l * DM, DM, DM, (GAS bf16*)(ws + WS_WOUT) + (size_t)l * DM * DM, scr, r, lane); }
    }
}

static_assert(36864 + 16 * (8 - 3) * 1536 <= 163840 - 64, "parked scan rows fit in LDS");
constexpr int PARK_M0 = 3, PARK_ROWS = 16 * (8 - PARK_M0), L_PARKH = 36864, L_PARKP = L_PARKH + PARK_ROWS * 1024, L_YT = 73728, L_RSTDV = L_YT + 67584, L_HIN = 0, L_MISC = LDS_BYTES - 64;

__device__ __forceinline__ void mixer_c(LAS unsigned char* lds, const GAS bf16* proj, const GAS bf16* waT, const GAS bf16* wxT, const GAS float* conv_w, const GAS float* conv_b,
                                        const GAS float* lba, const GAS float* lbx, const GAS float* lam, GAS bf16* hloc, GAS unsigned char* Pbuf, GAS float* aggL, GAS float* aggH, int T, int wid, int lane) {
    const int h = wid, g = lane >> 4, o = lane & 15, tt = T % TPS;
    const size_t R0 = (size_t)T * TILE;
    LAS unsigned char* cimg = lds + wid * 4608;
    bf16x8 WA[4][2], WX[4][2];
#pragma unroll
    for (int n = 0; n < 4; ++n)
#pragma unroll
        for (int kk = 0; kk < 2; ++kk) { const int idx = (h * 64 + 16 * n + o) * 64 + 32 * kk + 8 * g; WA[n][kk] = *(const GAS bf16x8*)(waT + idx); WX[n][kk] = *(const GAS bf16x8*)(wxT + idx); }
    float nba[4], nbx[4], psp[4], pspl[4], hc[4], Pc[4];
#pragma unroll
    for (int n = 0; n < 4; ++n) { const int c = 64 * h + 16 * n + o; nba[n] = -1.4426950408889634f * lba[c]; nbx[n] = -1.4426950408889634f * lbx[c];
        const float xm = -lam[c]; psp[n] = -8.0f * (fmaxf(xm, 0.f) + log1pf(expf(-fabsf(xm)))); pspl[n] = psp[n] * 1.4426950408889634f; hc[n] = 0.f; Pc[n] = 1.0f; }
#pragma unroll 1
    for (int half = 0; half < 4; ++half) {
        {
            const int oc = lane & 15, seg = lane >> 4, cc = 64 * h + 4 * oc;
            f32x4 cw0 = *(const GAS f32x4*)(conv_w + cc), cw1 = *(const GAS f32x4*)(conv_w + 512 + cc), cw2 = *(const GAS f32x4*)(conv_w + 1024 + cc), cw3 = *(const GAS f32x4*)(conv_w + 1536 + cc), cb = *(const GAS f32x4*)(conv_b + cc);
            const int t0 = 32 * half + 8 * seg;
            const GAS bf16* base = proj + (size_t)((OFF_CX + cc) >> 8) * PTILE + (R0 + t0) * 256 + ((OFF_CX + cc) & 255);
            const bool pv = (t0 > 0) || (tt > 0);
            v2u rw[11];
#pragma unroll
            for (int r = 0; r < 11; ++r) { rw[r] = (v2u){0u, 0u}; if (r >= 3 || pv) rw[r] = *(const GAS v2u*)(base + (r - 3) * 256); }
            f32x4 x0 = {bflo(rw[0].x), bfhi(rw[0].x), bflo(rw[0].y), bfhi(rw[0].y)}, x1 = {bflo(rw[1].x), bfhi(rw[1].x), bflo(rw[1].y), bfhi(rw[1].y)}, x2 = {bflo(rw[2].x), bfhi(rw[2].x), bflo(rw[2].y), bfhi(rw[2].y)};
#pragma unroll
            for (int r = 0; r < 8; ++r) {
                const v2u w = rw[r + 3]; const f32x4 cur = {bflo(w.x), bfhi(w.x), bflo(w.y), bfhi(w.y)};
                const f32x4 cv = cb + cw0 * x0 + cw1 * x1 + cw2 * x2 + cw3 * cur; x0 = x1; x1 = x2; x2 = cur;
                v2u ov; ov.x = pk2(cv.x, cv.y); ov.y = pk2(cv.z, cv.w);
                *(LAS v2u*)(cimg + (8 * seg + r) * 144 + oc * 8) = ov;
            }
        }
        asm volatile("s_waitcnt lgkmcnt(0)" ::: "memory");
#pragma unroll 1
        for (int mm = 0; mm < 2; ++mm) {
            const int m = 2 * half + mm;
            bf16x8 XA[2];
#pragma unroll
            for (int kk = 0; kk < 2; ++kk) XA[kk] = *(const LAS bf16x8*)(cimg + (16 * mm + o) * 144 + (32 * kk + 8 * g) * 2);
#pragma unroll
            for (int n = 0; n < 4; ++n) {
                f32x4 Da = {0.f, 0.f, 0.f, 0.f}, Dx = {0.f, 0.f, 0.f, 0.f};
                Da = MFMA16(XA[0], WA[n][0], Da); Da = MFMA16(XA[1], WA[n][1], Da);
                Dx = MFMA16(XA[0], WX[n][0], Dx); Dx = MFMA16(XA[1], WX[n][1], Dx);
                float aa[4], bb[4];
#pragma unroll
                for (int hp = 0; hp < 2; ++hp) {
                    const f32x2 da = {Da[2 * hp], Da[2 * hp + 1]}, dx = {Dx[2 * hp], Dx[2 * hp + 1]};
                    f32x2 ta = da * (-1.4426950408889634f) + nba[n], tx = dx * (-1.4426950408889634f) + nbx[n];
                    ta = __builtin_elementwise_min(__builtin_elementwise_max(ta, (f32x2){-40.f, -40.f}), (f32x2){40.f, 40.f}); tx = __builtin_elementwise_min(__builtin_elementwise_max(tx, (f32x2){-40.f, -40.f}), (f32x2){40.f, 40.f});
                    f32x2 ea, ex; ea.x = __builtin_amdgcn_exp2f(ta.x); ea.y = __builtin_amdgcn_exp2f(ta.y); ex.x = __builtin_amdgcn_exp2f(tx.x); ex.y = __builtin_amdgcn_exp2f(tx.y);
                    const f32x2 qa = ea + 1.0f, qx = ex + 1.0f, qq = qa * qx;
                    f32x2 rc; rc.x = __builtin_amdgcn_rcpf(qq.x); rc.y = __builtin_amdgcn_rcpf(qq.y);
                    const f32x2 r = qx * rc, ig = qa * rc;
                    const f32x2 la = r * psp[n], al = r * pspl[n], x2v = la + la;
                    f32x2 av; av.x = __builtin_amdgcn_exp2f(al.x); av.y = __builtin_amdgcn_exp2f(al.y);
                    f32x2 ser = x2v * 0.0083333338f + 0.041666668f; ser = ser * x2v + 0.16666667f; ser = ser * x2v + 0.5f; ser = ser * x2v + 1.0f; ser = ser * (-x2v);
                    const f32x2 fm = 1.0f - av * av;
                    f32x2 em; em.x = (x2v.x > -0.25f) ? ser.x : fm.x; em.y = (x2v.y > -0.25f) ? ser.y : fm.y;
                    f32x2 sq; sq.x = __builtin_amdgcn_sqrtf(em.x); sq.y = __builtin_amdgcn_sqrtf(em.y);
                    f32x2 cv; cv.x = bf2f(*(const LAS bf16*)(cimg + (16 * mm + 4 * g + 2 * hp) * 144 + (16 * n + o) * 2)); cv.y = bf2f(*(const LAS bf16*)(cimg + (16 * mm + 4 * g + 2 * hp + 1) * 144 + (16 * n + o) * 2));
                    const f32x2 bv = sq * ig * cv;
                    aa[2 * hp] = av.x; aa[2 * hp + 1] = av.y; bb[2 * hp] = bv.x; bb[2 * hp + 1] = bv.y;
                }
                float Hr[4], Ar[4], Hrun = 0.f, Arun = 1.0f;
#pragma unroll
                for (int reg = 0; reg < 4; ++reg) { Hrun = aa[reg] * Hrun + bb[reg]; Arun *= aa[reg]; Hr[reg] = Hrun; Ar[reg] = Arun; }
                float Ht = Hrun, At = Arun;
                { const float Hp = __shfl_up(Ht, 16), Ap = __shfl_up(At, 16); if (g >= 1) { Ht = At * Hp + Ht; At = Ap * At; } }
                { const float Hp = __shfl_up(Ht, 32), Ap = __shfl_up(At, 32); if (g >= 2) { Ht = At * Hp + Ht; At = Ap * At; } }
                float He = __shfl_up(Ht, 16), Ae = __shfl_up(At, 16); if (g == 0) { He = 0.f; Ae = 1.0f; }
                const float Hpre = Ae * hc[n] + He, Ppre = Pc[n] * Ae;
                float hv = 0.f, pv = 1.f;
                const size_t so = (R0 + 16 * m + 4 * g) * 512 + 64 * h + 16 * n + o;
#pragma unroll
                for (int reg = 0; reg < 4; ++reg) { hv = Hr[reg] + Ar[reg] * Hpre; pv = Ar[reg] * Ppre;
                    const bf16 hq = f2bf(hv); const unsigned char pq = (unsigned char)(pv * 255.0f + 0.5f);
                    if (m < PARK_M0) { hloc[so + reg * 512] = hq; Pbuf[so + reg * 512] = pq; }
                    else { const int pr = 16 * (m - PARK_M0) + 4 * g + reg, pc = 64 * h + 16 * n + o; *(LAS bf16*)(lds + L_PARKH + pr * 1024 + pc * 2) = hq; *(LAS unsigned char*)(lds + L_PARKP + pr * 512 + pc) = pq; } }
                hc[n] = __shfl(hv, 48 + o); Pc[n] = __shfl(pv, 48 + o);
            }
        }
    }
    if (g == 0) {
#pragma unroll
        for (int n = 0; n < 4; ++n) { const int c = 64 * h + 16 * n + o;
            __hip_atomic_store(aggL + (size_t)T * 512 + c, Pc[n], __ATOMIC_RELAXED, __HIP_MEMORY_SCOPE_AGENT); __hip_atomic_store(aggH + (size_t)T * 512 + c, hc[n], __ATOMIC_RELAXED, __HIP_MEMORY_SCOPE_AGENT); } }
    asm volatile("s_waitcnt vmcnt(0)" ::: "memory");
}

__device__ __forceinline__ void finish_rows(LAS unsigned char* ytile, const GAS bf16* mulp, const GAS bf16* zp, GAS bf16* outp, int tid) {
    const int c8 = 8 * (tid & 31), tb = tid >> 5;
#pragma unroll 4
    for (int i = 0; i < 8; ++i) { const int t = tb + 16 * i;
        float y[8], z[8]; unpack8(*(const LAS v4u*)(ytile + t * 528 + c8 * 2), y); unpack8(__builtin_nontemporal_load((const GAS v4u*)(zp + (size_t)t * 256 + c8)), z);
        if (mulp) { float u[8]; unpack8(__builtin_nontemporal_load((const GAS v4u*)(mulp + (size_t)t * 256 + c8)), u);
#pragma unroll
            for (int e = 0; e < 8; ++e) y[e] *= u[e]; }
        float ss = 0.f;
#pragma unroll
        for (int e = 0; e < 8; ++e) ss += y[e] * y[e];
        ss += __shfl_xor(ss, 1); ss += __shfl_xor(ss, 2); ss += __shfl_xor(ss, 4); ss += __shfl_xor(ss, 8); ss += __shfl_xor(ss, 16);
        const float rstd = __builtin_amdgcn_rsqf(ss * (1.0f / 256.0f) + EPS);
#pragma unroll
        for (int e = 0; e < 8; ++e) y[e] = y[e] * rstd * silu(z[e]);
        *(GAS v4u*)(outp + (size_t)t * DM + c8) = pack8(y); }
}

__device__ __forceinline__ void mixer_a(LAS unsigned char* lds, const GAS bf16* proj, const GAS bf16* sguW, const GAS float* sgu_g, const GAS float* sgu_b, GAS bf16* ybuf, int T, int tid, int wid, int lane) {
    const int g = lane >> 4, o = lane & 15;
    const size_t R0 = (size_t)T * TILE;
    LAS float* rstdv = (LAS float*)(lds + L_RSTDV); LAS unsigned char* ytile = lds + L_YT;
    { const int jo = tid & 15, co = tid >> 4;
        LAS float* part = (LAS float*)(lds + L_RSTDV + 512);
        float sg[8]; { const f32x4 a = *(const GAS f32x4*)(sgu_g + 8 * co), b = *(const GAS f32x4*)(sgu_g + 8 * co + 4); sg[0] = a.x; sg[1] = a.y; sg[2] = a.z; sg[3] = a.w; sg[4] = b.x; sg[5] = b.y; sg[6] = b.z; sg[7] = b.w; }
        v4u rows[8]; float rs[8];
#pragma unroll
        for (int r = 0; r < 8; ++r) rows[r] = __builtin_nontemporal_load((const GAS v4u*)(proj + (size_t)(OFF_AV >> 8) * PTILE + (R0 + 8 * jo + r) * 256 + 8 * co));
#pragma unroll
        for (int r = 0; r < 8; ++r) { float x[8]; unpack8(rows[r], x); float s = 0.f;
#pragma unroll
            for (int e = 0; e < 8; ++e) s += x[e] * x[e];
            s += __shfl_xor(s, 16); s += __shfl_xor(s, 32);
            if (lane < 16) part[wid * 128 + 8 * jo + r] = s; }
        __syncthreads();
        if (tid < 128) { float s = 0.f;
#pragma unroll
            for (int w = 0; w < 8; ++w) s += part[w * 128 + tid];
            rstdv[tid] = __builtin_amdgcn_rsqf(s * (1.0f / 256.0f) + EPS); }
        __syncthreads();
#pragma unroll
        for (int r = 0; r < 8; ++r) rs[r] = rstdv[8 * jo + r];
#pragma unroll
        for (int e = 0; e < 8; ++e) { float v[8];
#pragma unroll
            for (int r = 0; r < 8; ++r) { const unsigned w = rows[r][e >> 1]; v[r] = ((e & 1) ? bfhi(w) : bflo(w)) * rs[r] * sg[e]; }
            *(LAS v4u*)(lds + (8 * co + e) * 272 + 16 * jo) = pack8(v); }
    }
    __syncthreads();
    const int h = wid & 3, hf = wid >> 2;
    bf16x8 XW[4][4];
#pragma unroll
    for (int m = 0; m < 4; ++m)
#pragma unroll
        for (int kk = 0; kk < 4; ++kk) { XW[m][kk] = (bf16x8){0, 0, 0, 0, 0, 0, 0, 0}; if (kk < 2 || hf) XW[m][kk] = *(const GAS bf16x8*)(sguW + ((h * 128 + 64 * hf + 16 * m + o) * 128 + 8 * g) + 32 * kk); }
#pragma unroll
    for (int m = 0; m < 4; ++m) {
        f32x4 D[4];
#pragma unroll
        for (int n = 0; n < 4; ++n) D[n] = (f32x4){0.f, 0.f, 0.f, 0.f};
#pragma unroll
        for (int kk = 0; kk < 4; ++kk) if (kk < 2 || hf) {
#pragma unroll
            for (int n = 0; n < 4; ++n) { const bf16x8 Y = *(const LAS bf16x8*)(lds + (64 * h + 16 * n + o) * 272 + (32 * kk + 8 * g) * 2); D[n] = MFMA16(XW[m][kk], Y, D[n]); }
        }
        const int tb = 64 * hf + 16 * m + 4 * g;
        const f32x4 bias = *(const GAS f32x4*)(sgu_b + h * 128 + tb);
#pragma unroll
        for (int reg = 0; reg < 4; ++reg)
#pragma unroll
            for (int n = 0; n < 4; ++n) *(LAS bf16*)(ytile + (tb + reg) * 528 + (64 * h + 16 * n + o) * 2) = f2bf(D[n][reg] + bias[reg]);
    }
    __syncthreads();
    finish_rows(ytile, proj + (size_t)(OFF_AU >> 8) * PTILE + R0 * 256, proj + (size_t)(OFF_AZ >> 8) * PTILE + R0 * 256, ybuf + R0 * DM, tid);
}

__device__ __forceinline__ void mixer_b(LAS unsigned char* lds, const GAS bf16* proj, const GAS bf16* poolWT, const GAS float* pool_b, const GAS float* pool_s, GAS bf16* ybuf, int T, int tid, int wid, int lane) {
    const int g = lane >> 4, o = lane & 15, tt = T % TPS;
    const size_t R0 = (size_t)T * TILE;
    LAS unsigned char* ytile = lds + L_YT;
    {
        const int oc = tid & 31, seg = tid >> 5, grp = oc >> 3, win = 2 << grp, t0 = 8 * seg;
        const GAS bf16* base = proj + (size_t)(OFF_BX >> 8) * PTILE + R0 * 256 + 8 * oc;
        v4u R[23];
#pragma unroll
        for (int i = 0; i < 23; ++i) { const int t = t0 - 15 + i; R[i] = (v4u){0u, 0u, 0u, 0u}; if (i >= 16 - win && (t >= 0 || tt > 0)) R[i] = *(const GAS v4u*)(base + (long)t * 256); }
        float S[8];
#pragma unroll
        for (int e = 0; e < 8; ++e) S[e] = 0.f;
#pragma unroll
        for (int i = 0; i < 15; ++i) { float x[8]; unpack8(R[i], x);
#pragma unroll
            for (int e = 0; e < 8; ++e) S[e] += x[e]; }
        const int pos0 = tt * TILE + t0;
#pragma unroll
        for (int r = 0; r < 8; ++r) { float cur[8], pv[8], od[8]; unpack8(R[15 + r], cur);
            const int cnt = min(pos0 + r + 1, win); const float inv = 1.0f / (float)cnt;
#pragma unroll
            for (int e = 0; e < 8; ++e) { S[e] += cur[e]; pv[e] = S[e] * inv - cur[e]; }
            *(LAS v4u*)(lds + (t0 + r) * 528 + oc * 16) = pack8(pv);
            v4u ow = R[r];
            if (grp == 0) ow = R[14 + r]; else if (grp == 1) ow = R[12 + r]; else if (grp == 2) ow = R[8 + r];
            unpack8(ow, od);
#pragma unroll
            for (int e = 0; e < 8; ++e) S[e] -= od[e];
        }
    }
    __syncthreads();
    const int gg = wid & 3, hf = wid >> 2;
    bf16x8 Y[4][2]; float pb[4], ps[4];
#pragma unroll
    for (int n = 0; n < 4; ++n) { const int c = 64 * gg + 16 * n + o; pb[n] = pool_b[c]; ps[n] = pool_s[c];
#pragma unroll
        for (int kk = 0; kk < 2; ++kk) Y[n][kk] = *(const GAS bf16x8*)(poolWT + ((gg * 64 + 16 * n + o) * 64 + 32 * kk + 8 * g)); }
#pragma unroll 1
    for (int m = 0; m < 4; ++m) {
        f32x4 D[4];
#pragma unroll
        for (int n = 0; n < 4; ++n) D[n] = (f32x4){0.f, 0.f, 0.f, 0.f};
#pragma unroll
        for (int kk = 0; kk < 2; ++kk) { const bf16x8 X = *(const LAS bf16x8*)(lds + (64 * hf + 16 * m + o) * 528 + (64 * gg + 32 * kk + 8 * g) * 2);
#pragma unroll
            for (int n = 0; n < 4; ++n) D[n] = MFMA16(X, Y[n][kk], D[n]); }
        const int tb = 64 * hf + 16 * m + 4 * g;
#pragma unroll
        for (int reg = 0; reg < 4; ++reg)
#pragma unroll
            for (int n = 0; n < 4; ++n) *(LAS bf16*)(ytile + (tb + reg) * 528 + (64 * gg + 16 * n + o) * 2) = f2bf((D[n][reg] + pb[n]) * ps[n]);
    }
    __syncthreads();
    finish_rows(ytile, (const GAS bf16*)nullptr, proj + (size_t)(OFF_BZ >> 8) * PTILE + R0 * 256, ybuf + R0 * DM + 256, tid);
}

__device__ __forceinline__ void p3_tile(LAS unsigned char* lds, const GAS bf16* proj, const GAS bf16* hloc, const GAS unsigned char* Pbuf, const GAS float* aggL, const GAS float* aggH, const GAS unsigned* flags, GAS bf16* ybuf, int T, int tid, int wid, int lane) {
    const int tt = T % TPS; const size_t R0 = (size_t)T * TILE;
    LAS float* hin = (LAS float*)(lds + L_HIN);
    const int Tb = T - tt;
    if (tid < tt) { const GAS unsigned* fw = flags + 16 * (Tb + tid); unsigned sp = 0;
        while (__hip_atomic_load(fw, __ATOMIC_RELAXED, __HIP_MEMORY_SCOPE_AGENT) == 0u) { __builtin_amdgcn_s_sleep(2); if (++sp > (1u << 22)) break; } }
    __syncthreads();
    { float Lv[31], Hv[31], hcar = 0.f;
#pragma unroll
        for (int j = 0; j < 31; ++j) { Lv[j] = 0.f; Hv[j] = 0.f; if (j < tt) { Lv[j] = __hip_atomic_load(aggL + (size_t)(Tb + j) * 512 + tid, __ATOMIC_RELAXED, __HIP_MEMORY_SCOPE_AGENT); Hv[j] = __hip_atomic_load(aggH + (size_t)(Tb + j) * 512 + tid, __ATOMIC_RELAXED, __HIP_MEMORY_SCOPE_AGENT); } }
#pragma unroll
        for (int j = 0; j < 31; ++j) if (j < tt) hcar = Lv[j] * hcar + Hv[j];
        hin[tid] = hcar; }
    __syncthreads();
    float hi[8];
#pragma unroll
    for (int e = 0; e < 8; ++e) hi[e] = hin[8 * lane + e];
#pragma unroll 8
    for (int rr = 0; rr < 16; ++rr) { const int t = wid + 8 * rr; const size_t row = R0 + t;
        float hl[8], L[8], z[8], hv[8];
        v4u hw; v2u pw; if (t < 16 * PARK_M0) { hw = __builtin_nontemporal_load((const GAS v4u*)(hloc + row * 512 + 8 * lane)); pw = __builtin_nontemporal_load((const GAS v2u*)(Pbuf + row * 512 + 8 * lane)); } else { hw = *(const LAS v4u*)(lds + L_PARKH + (t - 16 * PARK_M0) * 1024 + 16 * lane); pw = *(const LAS v2u*)(lds + L_PARKP + (t - 16 * PARK_M0) * 512 + 8 * lane); }
        unpack8(hw, hl); {
#pragma unroll
            for (int e = 0; e < 8; ++e) L[e] = (float)(((e < 4 ? pw.x : pw.y) >> (8 * (e & 3))) & 0xffu) * (1.0f / 255.0f); } unpack8(__builtin_nontemporal_load((const GAS v4u*)(proj + (size_t)((OFF_CZ >> 8) + (lane >> 5)) * PTILE + row * 256 + 8 * (lane & 31))), z);
        float ss = 0.f;
#pragma unroll
        for (int e = 0; e < 8; ++e) { hv[e] = hl[e] + L[e] * hi[e]; ss += hv[e] * hv[e]; }
        ss = wave_sum(ss); const float rstd = __builtin_amdgcn_rsqf(ss * (1.0f / 512.0f) + EPS);
#pragma unroll
        for (int e = 0; e < 8; ++e) hv[e] = hv[e] * rstd * silu(z[e]);
        *(GAS v4u*)(ybuf + row * DM + 512 + 8 * lane) = pack8(hv);
    }
    __syncthreads();
}

#define XB_TMO      128
#define XB_XCNT(j)  (256  + 64 * (j))
#define XB_XSUB(j)  (1280 + 64 * (j))
#define XB_XGEN(j)  (2304 + 64 * (j))
#define XB_TOP      3328
#define XB_TOPGEN   3392
#define XCD_BAR_WORDS 3456
#define XB_SPIN_CAP (1u << 18)

__device__ __forceinline__ unsigned xb_ld(unsigned* p)              { return __hip_atomic_load(p, __ATOMIC_RELAXED, __HIP_MEMORY_SCOPE_AGENT); }
__device__ __forceinline__ unsigned xb_add(unsigned* p, unsigned v) { return __hip_atomic_fetch_add(p, v, __ATOMIC_RELAXED, __HIP_MEMORY_SCOPE_AGENT); }
__device__ __forceinline__ unsigned xb_xcc_id() { return (unsigned)__builtin_amdgcn_s_getreg((3 << 11) | 20) & 0xFu; }
#define XB_SPIN(cond, bar) do { unsigned _sp = 0; while (cond) { __builtin_amdgcn_s_sleep(1); \
    if ((++_sp & 255u) == 0u) { if (xb_ld(&(bar)[XB_TMO])) break; if (_sp > XB_SPIN_CAP) { atomicAdd(&(bar)[XB_TMO], 1u); break; } } } } while (0)

struct XcdBarrier {
    unsigned* bar; unsigned x;
    volatile LAS unsigned* st;
};

__device__ __forceinline__ XcdBarrier xcd_barrier_post(unsigned* bar, volatile LAS unsigned* st) {
    XcdBarrier b; b.bar = bar; b.x = xb_xcc_id(); b.st = st;
    if (threadIdx.x == 0) (void)xb_add(&bar[XB_XCNT(b.x)], 1u);
    return b;
}
__device__ __forceinline__ void xcd_barrier_complete(unsigned* bar, unsigned x, unsigned& nloc, unsigned& nx) {
    const unsigned G = gridDim.x * gridDim.y * gridDim.z;
    unsigned sum, cnt, mine, sp = 0u;
    for (;;) {
        sum = 0u; cnt = 0u; mine = 0u;
#pragma unroll
        for (unsigned j = 0; j < 16; ++j) { const unsigned c = xb_ld(&bar[XB_XCNT(j)]); sum += c; cnt += (c > 0u) ? 1u : 0u; mine = (j == x) ? c : mine; }
        if (sum == G) break;
        __builtin_amdgcn_s_sleep(1);
        if ((++sp & 255u) == 0u) { if (xb_ld(&bar[XB_TMO])) break; if (sp > XB_SPIN_CAP) { atomicAdd(&bar[XB_TMO], 1u); break; } }
    }
    nloc = mine > 0u ? mine : 1u; nx = cnt > 0u ? cnt : 1u;
}

__device__ __forceinline__ void xcd_barrier(const XcdBarrier& b) {
    asm volatile("s_waitcnt vmcnt(0)" ::: "memory");
    __syncthreads();
    if (threadIdx.x == 0) {
        unsigned* bar = b.bar;
        __builtin_amdgcn_s_waitcnt(0);
        unsigned nloc = b.st[0], nx = b.st[1];
        if (nloc == 0u) { xcd_barrier_complete(bar, b.x, nloc, nx); b.st[0] = nloc; b.st[1] = nx; }
        const unsigned old = xb_add(&bar[XB_XSUB(b.x)], 1u);
        const unsigned gen = old / nloc;
        if (old + 1u == (gen + 1u) * nloc) {
            __builtin_amdgcn_fence(__ATOMIC_RELEASE, "agent");
            asm volatile("s_waitcnt vmcnt(0)" ::: "memory");
            const unsigned og = xb_add(&bar[XB_TOP], 1u);
            const unsigned tg = og / nx;
            if (og + 1u == (tg + 1u) * nx) xb_add(&bar[XB_TOPGEN], 1u);
            else XB_SPIN(xb_ld(&bar[XB_TOPGEN]) == tg, bar);
            __builtin_amdgcn_fence(__ATOMIC_ACQUIRE, "agent");
            xb_add(&bar[XB_XGEN(b.x)], 1u);
            asm volatile("s_waitcnt vmcnt(0)" ::: "memory");
        } else {
            XB_SPIN(xb_ld(&bar[XB_XGEN(b.x)]) == gen, bar);
            __builtin_amdgcn_fence(__ATOMIC_ACQUIRE, "agent");
            asm volatile("s_waitcnt vmcnt(0)" ::: "memory");
        }
    }
    __syncthreads();
}

#ifndef REP_P0
#define REP_P0 1
#endif
#ifndef REP_P1
#define REP_P1 1
#endif
#ifndef REP_P2
#define REP_P2 1
#endif
#ifndef REP_P3
#define REP_P3 1
#endif
#ifndef REP_C
#define REP_C 1
#endif
#ifndef REP_A
#define REP_A 1
#endif
#ifndef REP_B
#define REP_B 1
#endif
#ifndef REP_F
#define REP_F 1
#endif
typedef __attribute__((address_space(4))) const unsigned long long* kptr_t;
__device__ __forceinline__ unsigned long long karg(int i) { kptr_t k = (kptr_t)__builtin_amdgcn_kernarg_segment_ptr(); asm volatile("" : "+s"(k)); return k[i]; }
#define KIN(i) ((const GAS float*)karg(i))
#define KOUT ((GAS float*)karg(19))
#define KWS ((GAS unsigned char*)karg(20))

__global__ void __launch_bounds__(NTHR, 2) hybrid_fwd(Params p) {
    extern __shared__ __attribute__((aligned(16))) unsigned char lds_raw[];
    cg::grid_group grid = cg::this_grid();
    LAS unsigned char* lds = (LAS unsigned char*)lds_raw;
    if (threadIdx.x < 16) ((LAS unsigned*)(lds + L_MISC))[threadIdx.x] = 0u;
    __syncthreads();
    const XcdBarrier bar = xcd_barrier_post((unsigned*)(KWS + WS_CTL), (volatile LAS unsigned*)(lds + L_MISC));
    if (gridDim.x == 0x7fffffffu) grid.sync();
#define GRID_BAR() xcd_barrier(bar)
#ifdef TS_A
#define STAMP(k) do { if (threadIdx.x == 0) ((volatile LAS unsigned*)(lds + L_MISC))[2 + (k)] = (unsigned)__builtin_amdgcn_s_memrealtime(); } while (0)
#else
#define STAMP(k) do {} while (0)
#endif
    STAMP(0);
#ifndef NO_P0
    for (int rep0 = 0; rep0 < REP_P0; ++rep0)
    { int tid = threadIdx.x; asm volatile("" : "+v"(tid)); p0_prologue(p, lds, tid, tid & 63, __builtin_amdgcn_readfirstlane(tid >> 6)); }
#endif
    GRID_BAR();
    STAMP(1);
#pragma unroll 1
    for (int l = 0; l < 2; ++l) {
#ifndef NO_P1
        for (int rep1 = 0; rep1 < REP_P1; ++rep1)
        {
            GAS unsigned char* ws = KWS;
            pg8::Gemm g{(const bf16*)(ws + WS_H), (const bf16*)(ws + WS_WIN) + (size_t)l * DIN * DM, MROWS, DIN, DM};
            pg8::EpiProj E{(GAS bf16*)(ws + WS_PROJ), (const GAS float*)(ws + WS_ROWSS) + l * MROWS, DIN};
            if (l == 0 && gridDim.x == 256) {
                if (blockIdx.x >= 128) { int td = threadIdx.x; asm volatile("" : "+v"(td)); p0b_convert(KIN(0), ws, (int)blockIdx.x - 128, td & 63, __builtin_amdgcn_readfirstlane(td >> 6)); }
                else { int td = threadIdx.x; asm volatile("" : "+v"(td)); p0_deferred(KIN(2) + (size_t)DM * DIN, KIN(1) + DM, KIN(17), KIN(16), ws, lds, 0, 128, td & 63, __builtin_amdgcn_readfirstlane(td >> 6)); }
                __syncthreads();
                pg8::PanelOrder S{(int)blockIdx.x, (const unsigned*)(ws + WS_CTL + CTL_READY), 8u};
                pg8::gemm_phase<pg8::EpiProj, pg8::PanelOrder, true, true>(lds, g, S, E);
            } else { pg8::StaticOrder S; S.init(MROWS, DIN, gridDim.x, (int)blockIdx.x);
                pg8::gemm_phase<pg8::EpiProj, pg8::StaticOrder, true, true>(lds, g, S, E); }
        }
#endif
        GRID_BAR();
        if (l == 0) STAMP(2);
#ifndef NO_P2
        for (int rep2 = 0; rep2 < REP_P2; ++rep2)
        for (int T = blockIdx.x; T < NTILES; T += gridDim.x) {
            int tid = threadIdx.x; asm volatile("" : "+v"(tid)); const int lane = tid & 63, wave = __builtin_amdgcn_readfirstlane(tid >> 6);
            GAS unsigned char* ws = KWS; const GAS bf16* proj = (const GAS bf16*)(ws + WS_PROJ); GAS bf16* ybuf = (GAS bf16*)(ws + WS_Y);
            GAS bf16* hloc = (GAS bf16*)(ws + WS_SCAN); GAS float* aggL = (GAS float*)(ws + WS_AGG); GAS unsigned* flags = (GAS unsigned*)(ws + WS_CTL + CTL_FLAGS) + l * NTILES * 16;
            mixer_c(lds, proj, (const GAS bf16*)(ws + WS_WA) + l * 8 * 4096, (const GAS bf16*)(ws + WS_WX) + l * 8 * 4096, KIN(9) + l * 4 * 512, KIN(10) + l * 512,
                    KIN(12) + l * 512, KIN(14) + l * 512, KIN(15) + l * 512, hloc, (GAS unsigned char*)(hloc + (size_t)MROWS * 512), aggL, aggL + NTILES * 512, T, wave, lane);
            __syncthreads();
            if (l == 0) STAMP(3);
            if (tid == 0) __hip_atomic_store(flags + 16 * T, 1u, __ATOMIC_RELAXED, __HIP_MEMORY_SCOPE_AGENT);
            p3_tile(lds, proj, hloc, (const GAS unsigned char*)(hloc + (size_t)MROWS * 512), aggL, aggL + NTILES * 512, flags, ybuf, T, tid, wave, lane);
            mixer_a(lds, proj, (const GAS bf16*)(ws + WS_SGUW) + l * 4 * 128 * 128, KIN(3) + l * 256, KIN(5) + l * 512, ybuf, T, tid, wave, lane);
            mixer_b(lds, proj, (const GAS bf16*)(ws + WS_POOLW) + l * 4 * 4096, KIN(7) + l * 256, KIN(8) + l * 256, ybuf, T, tid, wave, lane);
            __syncthreads();
        }
#endif
#ifdef TS_A
        if (l == 1 && blockIdx.x == 0 && threadIdx.x == 0) { volatile LAS unsigned* st = (volatile LAS unsigned*)(lds + L_MISC) + 2; *(unsigned*)(KWS + WS_CTL + CTL_DBG) = st[TS_B] - st[TS_A]; }
#endif
        GRID_BAR();
        if (l == 0) STAMP(7);
#ifndef NO_P4
        {
            GAS unsigned char* ws = KWS; GAS float* out = KOUT;
            pg8::Gemm g{(const bf16*)(ws + WS_Y), (const bf16*)(ws + WS_WOUT) + (size_t)l * DM * DM, MROWS, DM, DM}; pg8::StaticOrder S; S.init(MROWS, DM, gridDim.x, (int)blockIdx.x);
            if (l == 0) { pg8::EpiOut E{(GAS bf16*)(ws + WS_H), (GAS float*)(ws + WS_ROWSS) + MROWS};
                pg8::gemm_phase<pg8::EpiOut, pg8::StaticOrder, true, true>(lds, g, S, E); }
            else { pg8::EpiOutFinal E{(const GAS bf16*)(ws + WS_H), out, (GAS float*)(ws + WS_ROWSS) + 2 * MROWS, (GAS unsigned*)(ws + WS_CTL + CTL_PANEL), KIN(18), (const GAS unsigned*)(ws + WS_CTL + CTL_DBG)};
                pg8::gemm_phase<pg8::EpiOutFinal, pg8::StaticOrder, true, true>(lds, g, S, E); }
        }
#endif
        if (l == 0) { GRID_BAR(); STAMP(8); }
    }
}

extern "C" void kernel_launch(void* const* d_in, const int* in_sizes, int n_in, void* d_out, int out_size, void* d_ws, size_t ws_size, hipStream_t stream) {
    static int grid = 0;
    if (grid == 0) {
        int dev = 0, cus = 0, per_cu = 0;
        if (n_in != 19 || out_size != MROWS * DM || ws_size < WS_END) { fprintf(stderr, "kernel_launch: unexpected shapes (n_in %d out %d ws %zu)\n", n_in, out_size, ws_size); grid = -1; return; }
        hipGetDevice(&dev); hipDeviceGetAttribute(&cus, hipDeviceAttributeMultiprocessorCount, dev);
        if (hipFuncSetAttribute((const void*)hybrid_fwd, hipFuncAttributeMaxDynamicSharedMemorySize, LDS_BYTES) != hipSuccess) { fprintf(stderr, "kernel_launch: hipFuncSetAttribute failed\n"); }
        if (hipOccupancyMaxActiveBlocksPerMultiprocessor(&per_cu, (const void*)hybrid_fwd, NTHR, LDS_BYTES) != hipSuccess || per_cu < 1) per_cu = 1;
        (void)hipGetLastError();
        if (per_cu > 1) per_cu = 1;
        grid = cus * per_cu;
        if (grid < 1) grid = 256;
        if (grid != 256) { fprintf(stderr, "kernel_launch: built for a 256-CU device (one workgroup per CU); got a grid of %d, nothing launched\n", grid); grid = -1; return; }
    }
    if (grid < 0) return;
    Params p{};
    for (int i = 0; i < 19; ++i) p.in[i] = (const float*)d_in[i];
    p.out = (float*)d_out; p.ws = (unsigned char*)d_ws;
    if (hipMemsetAsync((char*)d_ws + WS_CTL, 0, CTL_BYTES, stream) != hipSuccess) { fprintf(stderr, "kernel_launch: memset failed\n"); return; }
    void* args[] = {&p};
    hipError_t e = hipLaunchCooperativeKernel((const void*)hybrid_fwd, dim3(grid), dim3(NTHR), args, LDS_BYTES, stream);
    if (e != hipSuccess) fprintf(stderr, "kernel_launch: cooperative launch failed: %s (grid %d)\n", hipGetErrorString(e), grid);
}
```
